# Optimizing an MI355X kernel written in HIP

```python
import jax, jax.numpy as jnp
from jax import lax
import numpy as np

D_MODEL = 2048
BATCH = 2
SEQ = 4096
DEPTH = 4

CTX_LEN = 256
GRID_W = 64
MIX_WIDTH = D_MODEL
M_WIDTH = MIX_WIDTH // 2
R_WIDTH = MIX_WIDTH - M_WIDTH
M_HEADS = 4
M_DV = M_WIDTH // M_HEADS
M_DQK = M_DV // 2
M_QK = M_HEADS * M_DQK
M_CHUNK = 64
R_BLOCKS = 16
R_BLOCK = R_WIDTH // R_BLOCKS
CONV_W = 4
CONV_PAD = (1, 2)
LRU_C = 8.0
EPS = 1e-6
IN_SIZES = (M_QK, M_QK, M_WIDTH, M_WIDTH, M_WIDTH, 4 * M_HEADS, R_WIDTH, R_WIDTH)
IN_WIDTH = sum(IN_SIZES)
IN_SPLITS = [int(s) for s in np.cumsum(IN_SIZES)[:-1]]

kernel_name = 'hymba_mlstm_rglru_prefix_dit'


def rmsnorm(t, g):
    tf = t.astype(jnp.float32)
    y = tf * lax.rsqrt(jnp.mean(tf * tf, axis=-1, keepdims=True) + EPS)
    return (y * g.astype(jnp.float32)).astype(t.dtype)


def dwconv(t, w, b):
    y = lax.conv_general_dilated(t, w[:, None, :].astype(t.dtype), (1,), [CONV_PAD],
                                 dimension_numbers=('NWC', 'WIO', 'NWC'),
                                 feature_group_count=t.shape[-1])
    return y + b.astype(t.dtype)


def to_col_major(t):
    b, n, ch = t.shape
    rows = n // GRID_W
    return t.reshape(b, rows, GRID_W, ch).transpose(0, 2, 1, 3).reshape(b, n, ch)


def to_row_major(t):
    b, n, ch = t.shape
    rows = n // GRID_W
    return t.reshape(b, GRID_W, rows, ch).transpose(0, 2, 1, 3).reshape(b, n, ch)


def mlstm_chunkwise(q, k, v, ig, lf, state):
    bsz, nh, t, _ = q.shape
    nc = t // M_CHUNK

    def chunks(a):
        a = a.reshape(a.shape[:2] + (nc, M_CHUNK) + a.shape[3:])
        return jnp.moveaxis(a, 2, 0)

    causal = jnp.tril(jnp.ones((M_CHUNK, M_CHUNK), dtype=bool))

    def step(carry, inp):
        c_st, n_st, m_st = carry
        qc, kc, vc, ic, fc = inp
        b = jnp.cumsum(fc, axis=-1)
        dmat = jnp.where(causal, b[..., :, None] - b[..., None, :] + ic[..., None, :], -jnp.inf)
        g = b + m_st[..., None]
        m_t = jnp.maximum(g, jnp.max(dmat, axis=-1))
        inter = jnp.exp(g - m_t)
        s = jnp.einsum('bhtd,bhsd->bhts', qc, kc) * jnp.exp(dmat - m_t[..., None])
        num = inter[..., None] * jnp.einsum('bhvd,bhtd->bhtv', c_st, qc) + jnp.einsum('bhts,bhsv->bhtv', s, vc)
        nq = inter * jnp.einsum('bhd,bhtd->bht', n_st, qc) + jnp.sum(s, axis=-1)
        h = num / jnp.maximum(jnp.abs(nq), jnp.exp(-m_t))[..., None]
        m_new = m_t[..., -1]
        w_s = jnp.exp(b[..., -1:] - b + ic - m_new[..., None])
        decay = jnp.exp(b[..., -1] + m_st - m_new)
        c_new = decay[..., None, None] * c_st + jnp.einsum('bhs,bhsv,bhsd->bhvd', w_s, vc, kc)
        n_new = decay[..., None] * n_st + jnp.einsum('bhs,bhsd->bhd', w_s, kc)
        return (c_new, n_new, m_new), h

    state, hs = lax.scan(step, state, (chunks(q), chunks(k), chunks(v), chunks(ig), chunks(lf)))
    hs = jnp.moveaxis(hs, 0, 2).reshape(bsz, nh, t, v.shape[-1])
    return hs, state


def mlstm_zero_state(bsz):
    f32 = jnp.float32
    return (jnp.zeros((bsz, M_HEADS, M_DV, M_DQK), f32), jnp.zeros((bsz, M_HEADS, M_DQK), f32),
            jnp.zeros((bsz, M_HEADS), f32))


def mlstm_inputs(qk_raw, v, gates, conv_w, conv_b, b_gate):
    f32 = jnp.float32
    qk = jax.nn.silu(dwconv(qk_raw, conv_w, conv_b)).astype(f32)
    q, k = jnp.split(qk, 2, axis=-1)

    def heads(a, dh):
        return a.reshape(a.shape[0], a.shape[1], M_HEADS, dh).transpose(0, 2, 1, 3)

    q = heads(q, M_DQK)
    k = heads(k, M_DQK) * (M_DQK ** -0.5)
    vh = heads(v.astype(f32), M_DV)
    gt = (gates.astype(f32) + b_gate.astype(f32)).transpose(0, 2, 1)
    i_f, f_f, i_b, f_b = jnp.split(gt, 4, axis=1)
    return q, k, vh, (i_f, jax.nn.log_sigmoid(f_f)), (i_b, jax.nn.log_sigmoid(f_b))


def mlstm_bidir(q, k, v, gf, gb, state_f, state_b):
    h_f, s_f = mlstm_chunkwise(q, k, v, gf[0], gf[1], state_f)
    fl = lambda a: jnp.flip(a, axis=2)
    h_b, s_b = mlstm_chunkwise(fl(q), fl(k), fl(v), fl(gb[0]), fl(gb[1]), state_b)
    return h_f + fl(h_b), s_f, s_b


def heads_to_seq(h):
    b, nh, t, dv = h.shape
    return h.transpose(0, 2, 1, 3).reshape(b, t, nh * dv)


def mlstm_out(hseq, o, z, g):
    f32 = jnp.float32
    b, t, _ = hseq.shape
    hh = hseq.reshape(b, t, M_HEADS, M_DV)
    hh = hh * lax.rsqrt(jnp.mean(hh * hh, axis=-1, keepdims=True) + EPS)
    hn = hh.reshape(b, t, M_WIDTH) * g.astype(f32)
    return hn * jax.nn.sigmoid(o.astype(f32)) * jax.nn.silu(z.astype(f32))


def _lin_comb(left, right):
    a_l, u_l = left
    a_r, u_r = right
    return a_l * a_r, a_r * u_l + u_r


def rglru(xc, w_r, b_r, w_i, b_i, lam, h0):
    bsz, t, ch = xc.shape
    xb = xc.reshape(bsz, t, R_BLOCKS, R_BLOCK)
    r = jax.nn.sigmoid(jnp.einsum('btgi,gij->btgj', xb, w_r).reshape(bsz, t, ch) + b_r)
    ii = jax.nn.sigmoid(jnp.einsum('btgi,gij->btgj', xb, w_i).reshape(bsz, t, ch) + b_i)
    log_a = -LRU_C * r * jax.nn.softplus(-lam)
    a = jnp.exp(log_a)
    u = jnp.sqrt(-jnp.expm1(2.0 * log_a)) * (ii * xc)
    a_cum, h = lax.associative_scan(_lin_comb, (a, u), axis=1)
    h = h + a_cum * h0[:, None, :]
    return h, h[:, -1]


def rglru_branch(xr_lat, xr_ctx, conv_w, conv_b, w_rg, b_rg, lam):
    f32 = jnp.float32
    xl = dwconv(xr_lat, conv_w, conv_b).astype(f32)
    xc = dwconv(xr_ctx, conv_w, conv_b).astype(f32)
    w_rg = w_rg.astype(f32)
    b_rg = b_rg.astype(f32)
    lam = lam.astype(f32)
    fwd = (w_rg[0, 0], b_rg[0, 0], w_rg[0, 1], b_rg[0, 1], lam[0])
    bwd = (w_rg[1, 0], b_rg[1, 0], w_rg[1, 1], b_rg[1, 1], lam[1])
    zeros = jnp.zeros((xc.shape[0], R_WIDTH), f32)
    h_cf, s_f = rglru(xc, *fwd, zeros)
    h_cb, s_b = rglru(jnp.flip(xc, 1), *bwd, zeros)
    h_lf, _ = rglru(xl, *fwd, s_f)
    h_lb, _ = rglru(jnp.flip(xl, 1), *bwd, s_b)
    return h_lf + jnp.flip(h_lb, 1), h_cf + jnp.flip(h_cb, 1)


def setup_inputs(seed: int = 0) -> dict:
    key = jax.random.key(seed)
    ks = jax.random.split(key, 24)
    f32 = jnp.float32
    L, D, H = DEPTH, D_MODEL, M_HEADS

    def nrm(k, shape, scale=1.0):
        return jax.random.normal(k, shape, f32) * scale

    f_bias = jnp.linspace(3.0, 6.0, H, dtype=f32)
    i_noise = nrm(ks[8], (L, 2, H), 0.01)
    f_noise = nrm(ks[9], (L, 2, H), 0.01)
    b_gate = jnp.concatenate([i_noise[:, 0], f_bias + f_noise[:, 0], i_noise[:, 1], f_bias + f_noise[:, 1]], axis=-1)
    u = jax.random.uniform(ks[15], (L, 2, R_WIDTH), f32, 0.9, 0.999)
    s = u ** (1.0 / LRU_C)
    lru_lambda = jnp.log(s) - jnp.log1p(-s)
    return {
        'x': nrm(ks[0], (BATCH, SEQ, D)),
        'c': nrm(ks[1], (BATCH, D)),
        'ctx': nrm(ks[2], (BATCH, CTX_LEN, D)),
        'c_ctx': nrm(ks[3], (D,)),
        'w_mod': nrm(ks[4], (L, D, 3 * D), D ** -0.5),
        'b_mod': nrm(ks[5], (L, 3 * D), 0.01),
        'norm_g': 1.0 + nrm(ks[6], (L, D), 0.01),
        'w_in': nrm(ks[7], (L, D, IN_WIDTH), D ** -0.5),
        'b_gate': b_gate,
        'conv_qk_w': nrm(ks[10], (L, CONV_W, 2 * M_QK), CONV_W ** -0.5),
        'conv_qk_b': nrm(ks[11], (L, 2 * M_QK), 0.01),
        'm_norm_g': 1.0 + nrm(ks[12], (L, M_WIDTH), 0.01),
        'conv_r_w': nrm(ks[13], (L, CONV_W, R_WIDTH), CONV_W ** -0.5),
        'conv_r_b': nrm(ks[14], (L, R_WIDTH), 0.01),
        'w_rg': nrm(ks[16], (L, 2, 2, R_BLOCKS, R_BLOCK, R_BLOCK), R_BLOCK ** -0.5),
        'b_rg': nrm(ks[17], (L, 2, 2, R_WIDTH), 0.01),
        'lru_lambda': lru_lambda,
        'w_out': nrm(ks[18], (L, MIX_WIDTH, D), MIX_WIDTH ** -0.5),
        'final_g': 1.0 + nrm(ks[19], (D,), 0.01),
    }


def reference(x, c, ctx, c_ctx, w_mod, b_mod, norm_g, w_in, b_gate, conv_qk_w, conv_qk_b, m_norm_g,
              conv_r_w, conv_r_b, w_rg, b_rg, lru_lambda, w_out, final_g):
    bsz = x.shape[0]
    for l in range(DEPTH):
        last = l == DEPTH - 1
        mod_x = jax.nn.silu(c) @ w_mod[l] + b_mod[l]
        mod_c = jax.nn.silu(c_ctx) @ w_mod[l] + b_mod[l]
        sh_x, sc_x, gt_x = jnp.split(mod_x[:, None, :], 3, axis=-1)
        sh_c, sc_c, gt_c = jnp.split(mod_c, 3, axis=-1)
        hx = rmsnorm(x, norm_g[l]) * (1.0 + sc_x) + sh_x
        hc = rmsnorm(ctx, norm_g[l]) * (1.0 + sc_c) + sh_c
        px = jnp.split(hx @ w_in[l], IN_SPLITS, axis=-1)
        pc = jnp.split(hc @ w_in[l], IN_SPLITS, axis=-1)

        qc_, kc_, vc_, gfc, gbc = mlstm_inputs(jnp.concatenate(pc[0:2], axis=-1), pc[2], pc[5],
                                               conv_qk_w[l], conv_qk_b[l], b_gate[l])
        h_c, st_f, st_b = mlstm_bidir(qc_, kc_, vc_, gfc, gbc, mlstm_zero_state(bsz), mlstm_zero_state(bsz))
        ql, kl, vl, gfl, gbl = mlstm_inputs(to_col_major(jnp.concatenate(px[0:2], axis=-1)),
                                            to_col_major(px[2]), to_col_major(px[5]),
                                            conv_qk_w[l], conv_qk_b[l], b_gate[l])
        h_l, _, _ = mlstm_bidir(ql, kl, vl, gfl, gbl, st_f, st_b)
        ym_x = mlstm_out(to_row_major(heads_to_seq(h_l)), px[3], px[4], m_norm_g[l])

        yr_x, yr_c = rglru_branch(px[6], pc[6], conv_r_w[l], conv_r_b[l], w_rg[l], b_rg[l], lru_lambda[l])
        yr_x = yr_x * jax.nn.silu(px[7].astype(jnp.float32))

        yx = jnp.concatenate([ym_x, yr_x], axis=-1).astype(x.dtype)
        x = x + gt_x * (yx @ w_out[l])
        if not last:
            ym_c = mlstm_out(heads_to_seq(h_c), pc[3], pc[4], m_norm_g[l])
            yr_c = yr_c * jax.nn.silu(pc[7].astype(jnp.float32))
            yc = jnp.concatenate([ym_c, yr_c], axis=-1).astype(ctx.dtype)
            ctx = ctx + gt_c * (yc @ w_out[l])
    return rmsnorm(x, final_g)
```

```cpp
#include <hip/hip_runtime.h>
#include <hip/hip_cooperative_groups.h>
#include <cstdio>
namespace cg = cooperative_groups;
__device__ __forceinline__ int ltid() { int t = threadIdx.x; asm volatile("" : "+v"(t)); return t; }
__device__ __forceinline__ int lbid() { int b = blockIdx.x; asm volatile("" : "+s"(b)); return b; }
namespace pg8 {
#define PG8_LAS __attribute__((address_space(3)))
typedef unsigned short bf16_t;
typedef short bf16x8 __attribute__((ext_vector_type(8)));
typedef float f32x4 __attribute__((ext_vector_type(4)));
typedef unsigned u32x4 __attribute__((ext_vector_type(4)));
constexpr int BM = 256, BK = 64, HALF = 128, HTB = HALF * BK * 2  , STAGE_BYTES = 8 * HTB, NXCD = 8, WGM = 8;

__host__ __device__ __forceinline__ int lds_byte(int r, int c) { const int st = (r >> 4) * 2 + (c >> 5), rr = r & 15, cc = c & 31, ob = rr * 64 + cc * 2; return st * 1024 + (ob ^ (((ob >> 9) & 1) << 5)); }
__host__ __device__ __forceinline__ void stage_rc(int b, int& R, int& C) { const int st = b / 1024, sb = b % 1024, swz = sb ^ (((sb >> 9) & 1) << 5); R = (st >> 1) * 16 + swz / 64; C = (st & 1) * 32 + (swz % 64) / 2; }
__host__ __device__ __forceinline__ int perm32(int rho) { const int n = rho >> 4, i = rho & 15; return 8 * (i >> 2) + 4 * n + (i & 3); }

struct Unit { int pm, pn; };
struct Gemm { const bf16_t* A; const bf16_t* Bt; int M, N, K, ld; };

struct StaticOrder {
    int nM, nN, nwg, G, c;
    __host__ __device__ void init(int M, int N, int G_, int c_) { nM = M / BM; nN = N / BM; nwg = nM * nN; G = G_; c = c_; }
    __host__ __device__ bool next(int i, Unit& u) const {
        const long L = (long)i * G + c; if (L >= nwg) return false;
        int wgid = (int)L; { const int q = nwg / NXCD, r = nwg % NXCD, xcd = wgid % NXCD, off = wgid / NXCD; wgid = (xcd < r ? xcd * (q + 1) : r * (q + 1) + (xcd - r) * q) + off; }
        const int nig = WGM * nN, gid = wgid / nig, fm = gid * WGM, gsz = (nM - fm) < WGM ? (nM - fm) : WGM;
        u.pm = fm + ((wgid % nig) % gsz); u.pn = (wgid % nig) / gsz; return true;
    }
    __device__ __forceinline__ void a_ready(const Unit&) const {}
    __device__ __forceinline__ void done(const Unit&) const {}
};
__device__ __forceinline__ unsigned cvt_pk_bf16(float lo, float hi) { unsigned r; asm volatile("v_cvt_pk_bf16_f32 %0, %1, %2" : "=v"(r) : "v"(lo), "v"(hi)); return r; }
template <class Epi, class Sched>
__device__ __forceinline__ void gemm_phase(PG8_LAS unsigned char* lds, const Gemm g, const Sched& S, const Epi& E) {
    const int tid = ltid(), wid = __builtin_amdgcn_readfirstlane(tid >> 6), lane = tid & 63, wr = wid >> 2, wc = wid & 3, fr = lane & 15, fq = lane >> 4;
    const int K = g.K, nt = K / BK;
    unsigned voffA[2], voffB[2];
#pragma unroll
    for (int i = 0; i < 2; ++i) { int R, C; stage_rc(tid * 16 + i * 8192, R, C); const int Rb = Epi::PERM ? ((R & ~31) + perm32(R & 31)) : R;
        voffA[i] = (unsigned)(R * g.ld + C) * 2u; voffB[i] = (unsigned)(Rb * g.ld + C) * 2u; }
    const size_t kstep = (size_t)(BK * 2);
    const size_t hstep = (size_t)HALF * g.ld * 2;
    const size_t tstep = 2 * hstep;
    const unsigned ldsw = (unsigned)wid * 1024u;
    const int aoff = lds_byte(wr * 64 + fr, fq * 8), boff = lds_byte(wc * 32 + fr, fq * 8);
#define PG8_SA(b, h) (((b) * 2 + (h)) * HTB)
#define PG8_SB(b, h) ((4 + (b) * 2 + (h)) * HTB)
#define PG8_STAGE(bufoff, gbase, voff) do { _Pragma("unroll") for (int _i = 0; _i < 2; ++_i) \
        __builtin_amdgcn_global_load_lds((const unsigned*)((const char*)(gbase) + (voff)[_i]), (PG8_LAS unsigned*)(lds + (bufoff) + ldsw + _i * 8192), 16, 0, 0); } while (0)
#define PG8_LDA(dst, b, h) do { _Pragma("unroll") for (int m = 0; m < 4; ++m) _Pragma("unroll") for (int k = 0; k < 2; ++k) dst[m][k] = *(const PG8_LAS bf16x8*)(lds + PG8_SA(b, h) + aoff + m * 2048 + k * 1024); } while (0)
#define PG8_LDB(dst, b, h) do { _Pragma("unroll") for (int n = 0; n < 2; ++n) _Pragma("unroll") for (int k = 0; k < 2; ++k) dst[n][k] = *(const PG8_LAS bf16x8*)(lds + PG8_SB(b, h) + boff + n * 2048 + k * 1024); } while (0)
#define PG8_MMA(ai, bj, At, Bt) do { __builtin_amdgcn_s_setprio(1); _Pragma("unroll") for (int m = 0; m < 4; ++m) _Pragma("unroll") for (int n = 0; n < 2; ++n) _Pragma("unroll") for (int k = 0; k < 2; ++k) \
        acc[ai][bj][m][n] = __builtin_amdgcn_mfma_f32_16x16x32_bf16(Bt[n][k], At[m][k], acc[ai][bj][m][n], 0, 0, 0); __builtin_amdgcn_s_setprio(0); } while (0)
#define PG8_WAIT_V(n) asm volatile("s_waitcnt vmcnt(" #n ")" ::: "memory")
#define PG8_WAIT_L(n) asm volatile("s_waitcnt lgkmcnt(" #n ")" ::: "memory")
#define PG8_BAR __builtin_amdgcn_s_barrier()
#define PG8_SCHED __builtin_amdgcn_sched_barrier(0)
    Unit cur, nxt; int ui = 0;
    if (!S.next(0, cur)) return;
    f32x4 acc[2][2][4][2];
#pragma unroll
    for (int a = 0; a < 2; ++a)
#pragma unroll
        for (int b = 0; b < 2; ++b)
#pragma unroll
            for (int m = 0; m < 4; ++m)
#pragma unroll
                for (int n = 0; n < 2; ++n) acc[a][b][m][n] = (f32x4){0.f, 0.f, 0.f, 0.f};
    bf16x8 At[4][2], B0[2][2], B1[2][2];
    const char* cA = (const char*)g.A + (size_t)cur.pm * tstep; const char* cB = (const char*)g.Bt + (size_t)cur.pn * tstep;
    S.a_ready(cur);
    PG8_STAGE(PG8_SB(0, 0), cB, voffB); PG8_STAGE(PG8_SA(0, 0), cA, voffA); PG8_STAGE(PG8_SB(0, 1), cB + hstep, voffB); PG8_STAGE(PG8_SA(0, 1), cA + hstep, voffA);
    if (wr == 1) PG8_BAR;
    PG8_WAIT_V(4); PG8_BAR;
    PG8_STAGE(PG8_SB(1, 0), cB + kstep, voffB); PG8_STAGE(PG8_SA(1, 0), cA + kstep, voffA); PG8_STAGE(PG8_SB(1, 1), cB + hstep + kstep, voffB);
    PG8_WAIT_V(6); PG8_BAR;
    for (;;) {
        const bool has_next = S.next(ui + 1, nxt);
        const char* nA = has_next ? (const char*)g.A + (size_t)nxt.pm * tstep : cA; const char* nB = has_next ? (const char*)g.Bt + (size_t)nxt.pn * tstep : cB;
        for (int t = 0; t < nt; t += 2) {
            const bool last = (t == nt - 2);
            const char* a1 = cA + (size_t)(t + 1) * kstep;
            const char* a2 = last ? nA : cA + (size_t)(t + 2) * kstep; const char* b2 = last ? nB : cB + (size_t)(t + 2) * kstep;
            const char* a3 = a2 + kstep; const char* b3 = b2 + kstep;
            if (last && has_next) S.a_ready(nxt);
            PG8_LDB(B0, 0, 0); PG8_SCHED; PG8_LDA(At, 0, 0); PG8_STAGE(PG8_SA(1, 1), a1 + hstep, voffA);
            PG8_WAIT_L(8); PG8_BAR; PG8_WAIT_L(0); PG8_MMA(0, 0, At, B0); PG8_BAR; PG8_SCHED;
            PG8_LDB(B1, 0, 1); PG8_STAGE(PG8_SB(0, 0), b2, voffB);
            PG8_BAR; PG8_WAIT_L(0); PG8_MMA(0, 1, At, B1); PG8_BAR;
            PG8_LDA(At, 0, 1); PG8_STAGE(PG8_SA(0, 0), a2, voffA);
            PG8_BAR; PG8_WAIT_L(0); PG8_MMA(1, 0, At, B0); PG8_BAR; PG8_SCHED;
            PG8_STAGE(PG8_SB(0, 1), b2 + hstep, voffB);
            PG8_WAIT_V(6); PG8_BAR; PG8_MMA(1, 1, At, B1); PG8_BAR;
            PG8_LDB(B0, 1, 0); PG8_SCHED; PG8_LDA(At, 1, 0); PG8_STAGE(PG8_SA(0, 1), a2 + hstep, voffA);
            PG8_WAIT_L(8); PG8_BAR; PG8_WAIT_L(0); PG8_MMA(0, 0, At, B0); PG8_BAR; PG8_SCHED;
            PG8_LDB(B1, 1, 1); PG8_STAGE(PG8_SB(1, 0), b3, voffB);
            PG8_BAR; PG8_WAIT_L(0); PG8_MMA(0, 1, At, B1); PG8_BAR;
            PG8_LDA(At, 1, 1); PG8_STAGE(PG8_SA(1, 0), a3, voffA);
            PG8_BAR; PG8_WAIT_L(0); PG8_MMA(1, 0, At, B0); PG8_BAR; PG8_SCHED;
            PG8_STAGE(PG8_SB(1, 1), b3 + hstep, voffB);
            PG8_WAIT_V(6); PG8_BAR; PG8_MMA(1, 1, At, B1); PG8_BAR;
        }
        if constexpr (!Epi::AFTER_DRAIN) { E(acc, cur, wr, wc, fr, fq); S.done(cur); }
        if (!has_next) break;
#pragma unroll
        for (int a = 0; a < 2; ++a)
#pragma unroll
            for (int b = 0; b < 2; ++b)
#pragma unroll
                for (int m = 0; m < 4; ++m)
#pragma unroll
                    for (int n = 0; n < 2; ++n) acc[a][b][m][n] = (f32x4){0.f, 0.f, 0.f, 0.f};
        cur = nxt; cA = nA; cB = nB; ++ui;
    }
    PG8_WAIT_V(0);
    if (wr == 0) PG8_BAR;
    PG8_BAR;
    if constexpr (Epi::AFTER_DRAIN) { E.fused(acc, cur, wr, wc, fr, fq, lds, wid, lane); S.done(cur); }
#undef PG8_SA
#undef PG8_SB
#undef PG8_STAGE
#undef PG8_LDA
#undef PG8_LDB
#undef PG8_MMA
#undef PG8_WAIT_V
#undef PG8_WAIT_L
#undef PG8_BAR
#undef PG8_SCHED
}
}

__device__ __forceinline__ float shx(float v, int m) {
    const int x = __float_as_int(v); int y;
    switch (m) {
        case 1: y = __builtin_amdgcn_ds_swizzle(x, (1 << 10) | 0x1f); break;
        case 2: y = __builtin_amdgcn_ds_swizzle(x, (2 << 10) | 0x1f); break;
        case 4: y = __builtin_amdgcn_ds_swizzle(x, (4 << 10) | 0x1f); break;
        case 8: y = __builtin_amdgcn_ds_swizzle(x, (8 << 10) | 0x1f); break;
        case 16: y = __builtin_amdgcn_ds_swizzle(x, (16 << 10) | 0x1f); break;
        default: return __shfl_xor(v, 32);
    }
    return __int_as_float(y);
}

#define DI __device__ __forceinline__
#define LAS __attribute__((address_space(3)))
typedef unsigned short bf16_t;
typedef short bf16x8 __attribute__((ext_vector_type(8)));
typedef float f32x4 __attribute__((ext_vector_type(4)));
typedef unsigned u32x4 __attribute__((ext_vector_type(4)));
typedef unsigned u32x2 __attribute__((ext_vector_type(2)));

#ifndef REP_M1
#define REP_M1 1
#endif
#ifndef REP_M3
#define REP_M3 1
#endif
#ifndef REP_R0
#define REP_R0 1
#endif
#ifndef REP_R1
#define REP_R1 1
#endif
#ifndef REP_M2
#define REP_M2 1
#endif
#ifndef REP_PREP
#define REP_PREP 1
#endif
#ifndef REP_G1
#define REP_G1 1
#endif
#ifndef REP_N
#define REP_N 1
#endif
#ifndef SINGLE_LAUNCH
#define SINGLE_LAUNCH 1
#endif
constexpr int NTOK = 8704, NPC = 6144, NG1 = 6400, DEPTH = 4, NPHASE = 26;
constexpr int LDS_BYTES = 147456;
constexpr size_t al256(size_t x) { return (x + 255) & ~(size_t)255; }
constexpr size_t WS_WIN = 0;
constexpr size_t WS_WOUT = WS_WIN + al256((size_t)4 * NG1 * 2048 * 2);
constexpr size_t WS_WRT = WS_WOUT + al256((size_t)4 * 2048 * 2048 * 2);
constexpr size_t WS_MOD = WS_WRT + al256((size_t)256 * 4096 * 2);
constexpr size_t MOD_BYTES = (size_t)4 * 3 * 6144 * 4;
constexpr size_t WS_HX = WS_MOD + al256(MOD_BYTES);
constexpr size_t WS_P = WS_HX + al256((size_t)NTOK * 2048 * 2);
constexpr size_t WS_GT = WS_P + al256((size_t)NTOK * NPC * 2);
constexpr size_t WS_XB = WS_GT + al256((size_t)NTOK * 16 * 4);
constexpr size_t WS_Y = WS_XB + al256((size_t)NTOK * 2048 * 4);
constexpr size_t WS_QC = WS_Y + al256((size_t)NTOK * 2048 * 2);
constexpr size_t WS_KC = WS_QC + al256((size_t)8 * 4352 * 128 * 2);
constexpr size_t WS_VT = WS_KC + al256((size_t)8 * 4352 * 128 * 2);
constexpr size_t WS_EG = WS_VT + al256((size_t)8 * 17 * 4 * 256 * 64 * 2);
constexpr size_t WS_BG = WS_EG + al256((size_t)16 * 4352 * 4);
constexpr size_t WS_JS = WS_BG + al256((size_t)16 * 4352 * 4);
constexpr size_t WS_DC = WS_JS + al256((size_t)272 * 2 * 4);
constexpr size_t WS_DN = WS_DC + al256((size_t)272 * 32768 * 4);
constexpr size_t WS_CIN = WS_DN + al256((size_t)272 * 128 * 4);
constexpr size_t WS_NIN = WS_CIN + al256((size_t)272 * 32768 * 2);
constexpr size_t WS_MIN = WS_NIN + al256((size_t)272 * 128 * 4);
constexpr size_t WS_RAGG = WS_MIN + al256((size_t)272 * 4);
constexpr size_t WS_LU = WS_RAGG + al256((size_t)34 * 2 * 1024 * 2 * 4);
constexpr size_t WS_PART = WS_LU + al256((size_t)2 * NTOK * 1024 * 4);
constexpr size_t WS_END = WS_PART + al256((size_t)8 * 512 * 2048 * 4);

struct Params {
    const float *x, *c, *ctx, *c_ctx, *w_mod, *b_mod, *norm_g, *w_in, *b_gate, *cqw, *cqb, *mng, *crw, *crb, *w_rg, *b_rg, *lam, *w_out, *final_g;
    float* out; unsigned char* ws; int ph_lo, ph_hi;
};

DI unsigned pk2(float lo, float hi) { unsigned r; asm("v_cvt_pk_bf16_f32 %0, %1, %2" : "=v"(r) : "v"(lo), "v"(hi)); return r; }
DI unsigned f2bf(float f) { return pk2(f, f) & 0xffffu; }
DI float bf2f(unsigned h) { return __uint_as_float(h << 16); }
DI float bflo(unsigned w) { return __uint_as_float(w << 16); }
DI float bfhi(unsigned w) { return __uint_as_float(w & 0xffff0000u); }
DI float sigm(float x) { return __builtin_amdgcn_rcpf(1.f + __expf(-x)); }
DI float one_m_expneg(float t, float a2) { const float pl = t * (1.f - t * 0.5f * (1.f - t * (1.f / 3.f) * (1.f - t * 0.25f * (1.f - t * 0.2f * (1.f - t * (1.f / 6.f) * (1.f - t * (1.f / 7.f))))))); return t < 0.25f ? pl : 1.f - a2; }
#define MFMA16(a, b, c) __builtin_amdgcn_mfma_f32_16x16x32_bf16((a), (b), (c), 0, 0, 0)
DI const float* xsrc(const Params& p, int l, int row) {
    if (l == 0) return row < 8192 ? p.x + (size_t)row * 2048 : p.ctx + (size_t)(row - 8192) * 2048;
    return (const float*)(p.ws + WS_XB) + (size_t)row * 2048;
}
DI int pos_row(int b, int pp) { if (pp < 256) return 8192 + b * 256 + pp; const int q = pp - 256; return b * 4096 + (q & 63) * 64 + (q >> 6); }

DI void tr_tile(LAS unsigned char* lds, const float* src, int ld_src, int k0, int n0, int ncols, bf16_t* dst, int ld_dst, int mode) {
    LAS bf16_t* T = (LAS bf16_t*)lds;
    const int tid = ltid(), kr = tid >> 4, nc = tid & 15;
    { const int n = n0 + 4 * nc; float4 v0 = make_float4(0.f, 0.f, 0.f, 0.f), v1 = v0;
      if (n < ncols) { v0 = *(const float4*)(src + (size_t)(k0 + 2 * kr) * ld_src + n); v1 = *(const float4*)(src + (size_t)(k0 + 2 * kr + 1) * ld_src + n); }
      LAS unsigned* T32 = (LAS unsigned*)lds;
      T32[(4 * nc + 0) * 36 + kr] = pk2(v0.x, v1.x); T32[(4 * nc + 1) * 36 + kr] = pk2(v0.y, v1.y);
      T32[(4 * nc + 2) * 36 + kr] = pk2(v0.z, v1.z); T32[(4 * nc + 3) * 36 + kr] = pk2(v0.w, v1.w); }
    __syncthreads();
    { const int n = tid >> 3, kc = tid & 7, sn = n0 + n;
      if (sn < ncols) { const int dr = mode == 1 ? (sn < 4096 ? sn : (sn < 4112 ? 6144 + sn - 4096 : sn - 16)) : sn;
          const u32x4 w = *(LAS u32x4*)(T + n * 72 + 8 * kc); *(u32x4*)(dst + (size_t)dr * ld_dst + k0 + 8 * kc) = w; } }
    __syncthreads();
}
DI void tr_tile4(LAS unsigned char* lds, const float* src, int ld_src, int k0, int n0, int ncols, bf16_t* dst, int ld_dst, int mode) {
    LAS unsigned* T32 = (LAS unsigned*)lds;
    const int tid = ltid(), kr = tid >> 4, nc = tid & 15;
    float4 v0[4], v1[4];
#pragma unroll
    for (int ti = 0; ti < 4; ++ti) { const int n = n0 + 64 * ti + 4 * nc; v0[ti] = make_float4(0.f, 0.f, 0.f, 0.f); v1[ti] = v0[ti];
        if (n < ncols) { v0[ti] = *(const float4*)(src + (size_t)(k0 + 2 * kr) * ld_src + n); v1[ti] = *(const float4*)(src + (size_t)(k0 + 2 * kr + 1) * ld_src + n); } }
#pragma unroll
    for (int ti = 0; ti < 4; ++ti) { LAS unsigned* T = T32 + ti * 2304;
        T[(4 * nc + 0) * 36 + kr] = pk2(v0[ti].x, v1[ti].x); T[(4 * nc + 1) * 36 + kr] = pk2(v0[ti].y, v1[ti].y);
        T[(4 * nc + 2) * 36 + kr] = pk2(v0[ti].z, v1[ti].z); T[(4 * nc + 3) * 36 + kr] = pk2(v0[ti].w, v1[ti].w); }
    __syncthreads();
    { const int n = tid >> 3, kc = tid & 7;
#pragma unroll
      for (int ti = 0; ti < 4; ++ti) { const int sn = n0 + 64 * ti + n;
          if (sn < ncols) { const int dr = mode == 1 ? (sn < 4096 ? sn : (sn < 4112 ? 6144 + sn - 4096 : sn - 16)) : sn;
              const u32x4 w = *(LAS u32x4*)((LAS bf16_t*)(T32 + ti * 2304) + n * 72 + 8 * kc); *(u32x4*)(dst + (size_t)dr * ld_dst + k0 + 8 * kc) = w; } } }
    __syncthreads();
}
DI void mod_task(LAS unsigned char* lds, const Params& p, int l, int cgp) {
    LAS float* red = (LAS float*)lds;
    const int tid = ltid(), kg = tid >> 4, cl = tid & 15, col = cgp * 64 + 4 * cl;
    const float* w = p.w_mod + ((size_t)l * 2048 + kg * 64) * 6144 + col;
    float4 a0 = make_float4(0.f, 0.f, 0.f, 0.f), a1 = a0, a2 = a0;
#pragma unroll 4
    for (int k = 0; k < 64; ++k) { const float4 v = *(const float4*)(w + (size_t)k * 6144); const int kk = kg * 64 + k;
        const float c0 = p.c[kk], c1 = p.c[2048 + kk], c2 = p.c_ctx[kk]; const float s0 = c0 * sigm(c0), s1 = c1 * sigm(c1), s2 = c2 * sigm(c2);
        a0.x += s0 * v.x; a0.y += s0 * v.y; a0.z += s0 * v.z; a0.w += s0 * v.w; a1.x += s1 * v.x; a1.y += s1 * v.y; a1.z += s1 * v.z; a1.w += s1 * v.w;
        a2.x += s2 * v.x; a2.y += s2 * v.y; a2.z += s2 * v.z; a2.w += s2 * v.w; }
    *(LAS f32x4*)(red + (kg * 3 + 0) * 64 + 4 * cl) = (f32x4){a0.x, a0.y, a0.z, a0.w}; *(LAS f32x4*)(red + (kg * 3 + 1) * 64 + 4 * cl) = (f32x4){a1.x, a1.y, a1.z, a1.w}; *(LAS f32x4*)(red + (kg * 3 + 2) * 64 + 4 * cl) = (f32x4){a2.x, a2.y, a2.z, a2.w};
    __syncthreads();
    if (tid < 192) { const int r = tid >> 6, c = tid & 63; float sum = 0.f;
#pragma unroll
        for (int g2 = 0; g2 < 32; ++g2) sum += red[(g2 * 3 + r) * 64 + c];
        const int col = cgp * 64 + c; const float v = sum + p.b_mod[(size_t)l * 6144 + col];
        ((float*)(p.ws + WS_MOD))[(size_t)l * 3 * 6144 + r * 6144 + col] = (col >= 2048 && col < 4096) ? (1.f + v) * p.norm_g[l * 2048 + col - 2048] : v; }
    __syncthreads();
}
DI void wconv_task(LAS unsigned char* lds, const Params& p, int l, int u) {
    if (u < 32 * 25) { const int kt = u / 25, ng = u % 25;
        tr_tile4(lds, p.w_in + (size_t)l * 2048 * 6160, 6160, kt * 64, ng * 256, 6160, (bf16_t*)(p.ws + WS_WIN) + (size_t)l * NG1 * 2048, 2048, 1); }
    else { const int r = u - 32 * 25, kt = r >> 3, ng = r & 7;
        tr_tile4(lds, p.w_out + (size_t)l * 2048 * 2048, 2048, kt * 64, ng * 256, 2048, (bf16_t*)(p.ws + WS_WOUT) + (size_t)l * 2048 * 2048, 2048, 0); }
}
constexpr int T_WCONV = 32 * 25 + 256;
DI void phase_prep(LAS unsigned char* lds, const Params& p) {
    constexpr int T_RG = 256, T_MOD = 4 * 96;
    for (int t = lbid(); t < T_MOD + T_WCONV + T_RG; t += gridDim.x) {
        if (t < T_MOD) { mod_task(lds, p, t / 96, t % 96); }
        else if (t < T_MOD + T_WCONV) wconv_task(lds, p, 0, t - T_MOD);
        else { const int m = t - T_MOD - T_WCONV; tr_tile(lds, p.w_rg + (size_t)m * 4096, 64, 0, 0, 64, (bf16_t*)(p.ws + WS_WRT) + (size_t)m * 4096, 64, 0); }
    }
}

DI float wave_sum(float v) { v += shx(v, 32); v += shx(v, 16); v += shx(v, 8); v += shx(v, 4); v += shx(v, 2); v += shx(v, 1); return v; }
DI void phase_norm(const Params& p, int l) {
    const int wid = ltid() >> 6, lane = ltid() & 63;
    const float* MOD = (const float*)(p.ws + WS_MOD) + (size_t)l * 3 * 6144; const float* bm = p.b_mod + (size_t)l * 6144; const float* g = p.norm_g + l * 2048;
    bf16_t* HX = (bf16_t*)(p.ws + WS_HX);
    for (int row = lbid() * 8 + wid; row < NTOK; row += gridDim.x * 8) {
        const int rt = row < 8192 ? (row >> 12) : 2;
        float4 v[8]; float ss = 0.f;
        if (l > 0 && row >= 8192) {
            const float* xo = xsrc(p, l - 1, row); const float* PART = (const float*)(p.ws + WS_PART) + (size_t)(row - 8192) * 2048;
            const float* MODp = (const float*)(p.ws + WS_MOD) + (size_t)(l - 1) * 3 * 6144 + 2 * 6144 + 4096; const float* bmp = p.b_mod + (size_t)(l - 1) * 6144 + 4096;
            float* XBw = (float*)(p.ws + WS_XB) + (size_t)row * 2048;
#pragma unroll
            for (int i = 0; i < 8; ++i) { const int c = (i * 64 + lane) * 4; float4 a = *(const float4*)(PART + c);
#pragma unroll
                for (int k = 1; k < 8; ++k) { const float4 t2 = *(const float4*)(PART + (size_t)k * 512 * 2048 + c); a.x += t2.x; a.y += t2.y; a.z += t2.z; a.w += t2.w; }
                const float4 x0 = *(const float4*)(xo + c), g1 = *(const float4*)(MODp + c);
                v[i].x = x0.x + g1.x * a.x; v[i].y = x0.y + g1.y * a.y; v[i].z = x0.z + g1.z * a.z; v[i].w = x0.w + g1.w * a.w;
                *(float4*)(XBw + c) = v[i]; }
        } else { const float* xs = xsrc(p, l, row);
#pragma unroll
            for (int i = 0; i < 8; ++i) v[i] = *(const float4*)(xs + (i * 64 + lane) * 4); }
#pragma unroll
        for (int i = 0; i < 8; ++i) ss += v[i].x * v[i].x + v[i].y * v[i].y + v[i].z * v[i].z + v[i].w * v[i].w;
        ss = wave_sum(ss);
        const float rstd = rsqrtf(ss * (1.f / 2048.f) + 1e-6f);
#pragma unroll
        for (int i = 0; i < 8; ++i) { const int c = (i * 64 + lane) * 4;
            const float4 sh = *(const float4*)(MOD + rt * 6144 + c), sc = *(const float4*)(MOD + rt * 6144 + 2048 + c);
            const float y0 = v[i].x * rstd * sc.x + sh.x, y1 = v[i].y * rstd * sc.y + sh.y;
            const float y2 = v[i].z * rstd * sc.z + sh.z, y3 = v[i].w * rstd * sc.w + sh.w;
            u32x2 w; w.x = pk2(y0, y1); w.y = pk2(y2, y3); *(u32x2*)(HX + (size_t)row * 2048 + c) = w; }
    }
}
DI void phase_final(const Params& p) {
    const int wid = ltid() >> 6, lane = ltid() & 63;
    const float* XB = (const float*)(p.ws + WS_XB);
    for (int row = lbid() * 8 + wid; row < 8192; row += gridDim.x * 8) {
        const float* xs = XB + (size_t)row * 2048; float4 v[8]; float ss = 0.f;
#pragma unroll
        for (int i = 0; i < 8; ++i) { v[i] = *(const float4*)(xs + (i * 64 + lane) * 4); ss += v[i].x * v[i].x + v[i].y * v[i].y + v[i].z * v[i].z + v[i].w * v[i].w; }
        ss = wave_sum(ss);
        const float rstd = rsqrtf(ss * (1.f / 2048.f) + 1e-6f);
#pragma unroll
        for (int i = 0; i < 8; ++i) { const int c = (i * 64 + lane) * 4; const float4 gg = *(const float4*)(p.final_g + c);
            float4 o; o.x = v[i].x * rstd * gg.x; o.y = v[i].y * rstd * gg.y; o.z = v[i].z * rstd * gg.z; o.w = v[i].w * rstd * gg.w; *(float4*)(p.out + (size_t)row * 2048 + c) = o; }
    }
}

struct EpiIn {
    static constexpr bool PERM = true, AFTER_DRAIN = false;
    bf16_t* P; float* GT;
    DI void operator()(const f32x4 (&acc)[2][2][4][2], const pg8::Unit& u, int wr, int wc, int fr, int fq) const {
        const int row0 = u.pm * 256 + wr * 64 + fr;
        if (u.pn < 24) { const int col0 = u.pn * 256 + wc * 32 + 8 * fq;
#pragma unroll
            for (int ai = 0; ai < 2; ++ai)
#pragma unroll
                for (int m = 0; m < 4; ++m) { bf16_t* rowp = P + (size_t)(row0 + ai * 128 + m * 16) * NPC + col0;
#pragma unroll
                    for (int bj = 0; bj < 2; ++bj) { const f32x4 v0 = acc[ai][bj][m][0], v1 = acc[ai][bj][m][1];
                        u32x4 w; w.x = pg8::cvt_pk_bf16(v0[0], v0[1]); w.y = pg8::cvt_pk_bf16(v0[2], v0[3]); w.z = pg8::cvt_pk_bf16(v1[0], v1[1]); w.w = pg8::cvt_pk_bf16(v1[2], v1[3]);
                        *(u32x4*)(rowp + bj * 128) = w; } }
        } else if (wc == 0 && fq < 2) {
#pragma unroll
            for (int ai = 0; ai < 2; ++ai)
#pragma unroll
                for (int m = 0; m < 4; ++m) { float* rp = GT + (size_t)(row0 + ai * 128 + m * 16) * 16 + 8 * fq; *(f32x4*)rp = acc[ai][0][m][0]; *(f32x4*)(rp + 4) = acc[ai][0][m][1]; }
        }
    }
};
struct EpiOut {
    static constexpr bool PERM = false, AFTER_DRAIN = false;
    Params p; int l;
    DI void operator()(const f32x4 (&acc)[2][2][4][2], const pg8::Unit& u, int wr, int wc, int fr, int fq) const {
        const int row0 = u.pm * 256 + wr * 64 + fr, col0 = u.pn * 256 + wc * 32 + 4 * fq, rt = u.pm < 32 ? (u.pm >> 4) : 2;
        const float* MOD = (const float*)(p.ws + WS_MOD) + (size_t)l * 3 * 6144 + rt * 6144 + 4096; const float* bm = p.b_mod + (size_t)l * 6144 + 4096;
        f32x4 gt[2][2];
#pragma unroll
        for (int bj = 0; bj < 2; ++bj)
#pragma unroll
            for (int n = 0; n < 2; ++n) gt[bj][n] = *(const f32x4*)(MOD + col0 + bj * 128 + n * 16);
        float* XB = (float*)(p.ws + WS_XB);
#pragma unroll
        for (int ai = 0; ai < 2; ++ai)
#pragma unroll
            for (int m = 0; m < 4; ++m) { const int r = row0 + ai * 128 + m * 16; const float* xs = xsrc(p, l, r) + col0; float* xo = XB + (size_t)r * 2048 + col0;
#pragma unroll
                for (int bj = 0; bj < 2; ++bj)
#pragma unroll
                    for (int n = 0; n < 2; ++n) { const f32x4 o = *(const f32x4*)(xs + bj * 128 + n * 16) + gt[bj][n] * acc[ai][bj][m][n]; *(f32x4*)(xo + bj * 128 + n * 16) = o; } }
    }
};

struct OneUnit { int pm, pn;
    DI bool next(int i, pg8::Unit& u) const { if (i) return false; u.pm = pm; u.pn = pn; return true; }
    DI void a_ready(const pg8::Unit&) const {}
    DI void done(const pg8::Unit&) const {} };
struct EpiPart {
    static constexpr bool PERM = false, AFTER_DRAIN = false;
    float* part;
    DI void operator()(const f32x4 (&acc)[2][2][4][2], const pg8::Unit& u, int wr, int wc, int fr, int fq) const {
        const int row0 = (u.pm - 32) * 256 + wr * 64 + fr, col0 = u.pn * 256 + wc * 32 + 4 * fq;
#pragma unroll
        for (int ai = 0; ai < 2; ++ai)
#pragma unroll
            for (int m = 0; m < 4; ++m) { float* xo = part + (size_t)(row0 + ai * 128 + m * 16) * 2048 + col0;
#pragma unroll
                for (int bj = 0; bj < 2; ++bj)
#pragma unroll
                    for (int n = 0; n < 2; ++n) *(f32x4*)(xo + bj * 128 + n * 16) = acc[ai][bj][m][n]; }
    }
};

DI void m1_task(LAS unsigned char* lds, const Params& p, int l, int task) {
    const int dir = task & 1, J = (task >> 1) % 17, bh = (task >> 1) / 17, b = bh >> 2, h = bh & 3;
    const int chain = bh * 2 + dir, sidx = chain * 17 + J;
    const int tid = ltid(), wid = tid >> 6, lane = tid & 63, r = lane & 15, q = lane >> 4;
    LAS bf16_t* Ktw = (LAS bf16_t*)lds;
    LAS bf16_t* Vts = (LAS bf16_t*)(lds + 18432);
    LAS float* wv = (LAS float*)(lds + 55296);
    LAS float* sc = (LAS float*)(lds + 56320);
    const bf16_t* P = (const bf16_t*)(p.ws + WS_P); const float* GT = (const float*)(p.ws + WS_GT);
    float* EG = (float*)(p.ws + WS_EG); float* BG = (float*)(p.ws + WS_BG); float* JS = (float*)(p.ws + WS_JS);
    float e_val = 0.f, bsum = 0.f; const int idx = dir ? 255 - tid : tid;
    if (tid < 256) {
        const int row = pos_row(b, J * 256 + idx);
        const float ig = GT[(size_t)row * 16 + dir * 8 + h] + p.b_gate[l * 16 + dir * 8 + h];
        const float fg = GT[(size_t)row * 16 + dir * 8 + 4 + h] + p.b_gate[l * 16 + dir * 8 + 4 + h];
        float s = fminf(fg, 0.f) - __logf(1.f + __expf(-fabsf(fg)));
#pragma unroll
        for (int o = 1; o < 64; o <<= 1) { const float t = __shfl_up(s, o); if (lane >= o) s += t; }
        if (lane == 63) sc[wid] = s;
        bsum = s; e_val = ig;
    }
    __syncthreads();
    if (tid < 256) { float off = 0.f; for (int w = 0; w < wid; ++w) off += sc[w]; bsum += off; e_val -= bsum;
        EG[(size_t)chain * 4352 + J * 256 + idx] = e_val; BG[(size_t)chain * 4352 + J * 256 + idx] = bsum;
        float m = e_val;
#pragma unroll
        for (int o = 32; o; o >>= 1) m = fmaxf(m, shx(m, o));
        if (lane == 0) sc[8 + wid] = m; }
    __syncthreads();
    const float emax = fmaxf(fmaxf(sc[8], sc[9]), fmaxf(sc[10], sc[11])), Btot = sc[0] + sc[1] + sc[2] + sc[3];
    if (tid < 256) wv[idx] = __expf(e_val - emax);
    if (tid == 0) { JS[sidx * 2] = Btot; JS[sidx * 2 + 1] = Btot + emax; }
    __syncthreads();
    f32x4 acc[2][8];
#pragma unroll
    for (int a = 0; a < 2; ++a)
#pragma unroll
        for (int n = 0; n < 8; ++n) acc[a][n] = (f32x4){0.f, 0.f, 0.f, 0.f};
    float dn_acc = 0.f;
    const int seq_lo = (J == 0) ? 0 : 256, seq_hi = (J == 0) ? 256 : 4352;
    bf16_t* QC = (bf16_t*)(p.ws + WS_QC); bf16_t* KC = (bf16_t*)(p.ws + WS_KC); bf16_t* VT = (bf16_t*)(p.ws + WS_VT);
#pragma unroll 1
    for (int sb = 0; sb < 4; ++sb) {
        u32x4 rv[4];
        { const bf16_t* vsrc = P + (size_t)pos_row(b, J * 256 + sb * 64 + (tid & 63)) * NPC + 1024 + h * 256 + (tid >> 6) * 32;
#pragma unroll
          for (int i = 0; i < 4; ++i) rv[i] = *(const u32x4*)(vsrc + 8 * i); }
        { const int s = tid & 63, dg = __builtin_amdgcn_readfirstlane(tid >> 6), pl = sb * 64 + s, pp = J * 256 + pl;
#pragma unroll 1
          for (int which = (dir == 0 ? 0 : 1); which < 2; ++which) {
              const int cbase = which * 512 + h * 128 + dg * 16;
              float a[16];
#pragma unroll
              for (int i = 0; i < 16; i += 4) { const float4 bb = *(const float4*)(p.cqb + l * 1024 + cbase + i); a[i] = bb.x; a[i + 1] = bb.y; a[i + 2] = bb.z; a[i + 3] = bb.w; }
#pragma unroll
              for (int j = 0; j < 4; ++j) { const int pq = pp - 1 + j;
                  if (pq >= seq_lo && pq < seq_hi) { const bf16_t* src = P + (size_t)pos_row(b, pq) * NPC + cbase; const float* wp = p.cqw + (size_t)(l * 4 + j) * 1024 + cbase;
#pragma unroll
                      for (int i8 = 0; i8 < 2; ++i8) { const u32x4 w = *(const u32x4*)(src + 8 * i8); const float4 w0 = *(const float4*)(wp + 8 * i8), w1 = *(const float4*)(wp + 8 * i8 + 4);
                          a[8 * i8 + 0] += w0.x * bflo(w.x); a[8 * i8 + 1] += w0.y * bfhi(w.x); a[8 * i8 + 2] += w0.z * bflo(w.y); a[8 * i8 + 3] += w0.w * bfhi(w.y);
                          a[8 * i8 + 4] += w1.x * bflo(w.z); a[8 * i8 + 5] += w1.y * bfhi(w.z); a[8 * i8 + 6] += w1.z * bflo(w.w); a[8 * i8 + 7] += w1.w * bfhi(w.w); } } }
              const float scale = which ? 0.08838834764831845f : 1.f;
#pragma unroll
              for (int i = 0; i < 16; ++i) a[i] = a[i] * sigm(a[i]) * scale;
              u32x4 o0, o1; o0.x = pk2(a[0], a[1]); o0.y = pk2(a[2], a[3]); o0.z = pk2(a[4], a[5]); o0.w = pk2(a[6], a[7]);
              o1.x = pk2(a[8], a[9]); o1.y = pk2(a[10], a[11]); o1.z = pk2(a[12], a[13]); o1.w = pk2(a[14], a[15]);
              if (which == 0) { bf16_t* dst = QC + ((size_t)bh * 4352 + pp) * 128 + dg * 16; *(u32x4*)dst = o0; *(u32x4*)(dst + 8) = o1; }
              else { if (dir == 0) { bf16_t* dst = KC + ((size_t)bh * 4352 + pp) * 128 + dg * 16; *(u32x4*)dst = o0; *(u32x4*)(dst + 8) = o1; }
                  const float ws_ = wv[pl];
#pragma unroll
                  for (int i = 0; i < 16; ++i) Ktw[(dg * 16 + i) * 72 + s] = (bf16_t)f2bf(bf2f(f2bf(a[i])) * ws_); }
          } }
        { const int s = tid & 63, vg = tid >> 6;
#pragma unroll
          for (int i = 0; i < 4; ++i) { const u32x4 w = rv[i];
              Vts[(vg * 32 + 8 * i + 0) * 72 + s] = (bf16_t)(w.x & 0xffff); Vts[(vg * 32 + 8 * i + 1) * 72 + s] = (bf16_t)(w.x >> 16);
              Vts[(vg * 32 + 8 * i + 2) * 72 + s] = (bf16_t)(w.y & 0xffff); Vts[(vg * 32 + 8 * i + 3) * 72 + s] = (bf16_t)(w.y >> 16);
              Vts[(vg * 32 + 8 * i + 4) * 72 + s] = (bf16_t)(w.z & 0xffff); Vts[(vg * 32 + 8 * i + 5) * 72 + s] = (bf16_t)(w.z >> 16);
              Vts[(vg * 32 + 8 * i + 6) * 72 + s] = (bf16_t)(w.w & 0xffff); Vts[(vg * 32 + 8 * i + 7) * 72 + s] = (bf16_t)(w.w >> 16); } }
        __syncthreads();
        if (dir == 0) { const int v = tid >> 1, half = tid & 1; bf16_t* dst = VT + ((((size_t)bh * 17 + J) * 4 + sb) * 256 + v) * 64 + half * 32;
#pragma unroll
            for (int i = 0; i < 4; ++i) *(u32x4*)(dst + 8 * i) = *(LAS u32x4*)(Vts + v * 72 + half * 32 + 8 * i); }
        if (tid < 128) { float sum = 0.f;
#pragma unroll
            for (int i = 0; i < 8; ++i) { const u32x4 w = *(LAS u32x4*)(Ktw + tid * 72 + 8 * i); sum += bflo(w.x) + bfhi(w.x) + bflo(w.y) + bfhi(w.y) + bflo(w.z) + bfhi(w.z) + bflo(w.w) + bfhi(w.w); }
            dn_acc += sum; }
#pragma unroll 1
        for (int ks = 0; ks < 2; ++ks) { bf16x8 A[2];
#pragma unroll
            for (int mt = 0; mt < 2; ++mt) A[mt] = *(LAS bf16x8*)(Vts + (32 * wid + 16 * mt + r) * 72 + 32 * ks + 8 * q);
#pragma unroll
            for (int nt = 0; nt < 8; ++nt) { const bf16x8 B = *(LAS bf16x8*)(Ktw + (16 * nt + r) * 72 + 32 * ks + 8 * q);
                acc[0][nt] = MFMA16(B, A[0], acc[0][nt]); acc[1][nt] = MFMA16(B, A[1], acc[1][nt]); } }
        __syncthreads();
    }
    bf16_t* DC = (bf16_t*)(p.ws + WS_DC) + (size_t)sidx * 32768;
#pragma unroll
    for (int mt = 0; mt < 2; ++mt)
#pragma unroll
        for (int nt = 0; nt < 8; ++nt) { u32x2 w; w.x = pk2(acc[mt][nt][0], acc[mt][nt][1]); w.y = pk2(acc[mt][nt][2], acc[mt][nt][3]);
            *(u32x2*)(DC + (32 * wid + 16 * mt + r) * 128 + 16 * nt + 4 * q) = w; }
    if (tid < 128) ((float*)(p.ws + WS_DN))[(size_t)sidx * 128 + tid] = dn_acc;
}

DI void phase_m2(const Params& p) {
    const float* JS = (const float*)(p.ws + WS_JS); const bf16_t* DC = (const bf16_t*)(p.ws + WS_DC); const float* DN = (const float*)(p.ws + WS_DN);
    bf16_t* CIN = (bf16_t*)(p.ws + WS_CIN); float* NIN = (float*)(p.ws + WS_NIN); float* MIN_ = (float*)(p.ws + WS_MIN);
    for (int item = lbid() * 512 + ltid(); item < 131072 + 512; item += gridDim.x * 512) {
        const bool isn = item >= 131072; int chain, off;
        if (!isn) { chain = item >> 13; off = (item & 8191) * 4; } else { const int it = item - 131072; chain = it >> 5; off = (it & 31) * 4; }
        const int dir = chain & 1;
        float4 C = make_float4(0.f, 0.f, 0.f, 0.f); float m = -1e30f;
#pragma unroll
        for (int step = 0; step < 17; ++step) {
            const int J = step == 0 ? 0 : (dir ? 17 - step : step), sidx = chain * 17 + J;
            if (!isn) { u32x2 w; w.x = pk2(C.x, C.y); w.y = pk2(C.z, C.w); *(u32x2*)(CIN + (size_t)sidx * 32768 + off) = w; if (off == 0) MIN_[sidx] = m; }
            else *(float4*)(NIN + (size_t)sidx * 128 + off) = C;
            const float Bt = JS[sidx * 2], ml = JS[sidx * 2 + 1], mn = fmaxf(Bt + m, ml), a = __expf(Bt + m - mn), bb = __expf(ml - mn);
            float4 d;
            if (isn) d = *(const float4*)(DN + (size_t)sidx * 128 + off);
            else { const u32x2 w = *(const u32x2*)(DC + (size_t)sidx * 32768 + off); d = make_float4(bflo(w.x), bfhi(w.x), bflo(w.y), bfhi(w.y)); }
            C.x = a * C.x + bb * d.x; C.y = a * C.y + bb * d.y; C.z = a * C.z + bb * d.z; C.w = a * C.w + bb * d.w; m = mn;
        }
    }
}

DI void m3_task(LAS unsigned char* lds, const Params& p, int l, int task) {
    const int tb = task & 3, J = (task >> 2) % 17, bh = (task >> 2) / 17, b = bh >> 2, h = bh & 3;
    const int tid = ltid(), wid = tid >> 6, lane = tid & 63, r = lane & 15, q = lane >> 4;
    LAS bf16_t* Qs = (LAS bf16_t*)lds;
    LAS bf16_t* Ks = (LAS bf16_t*)(lds + 17408);
    LAS bf16_t* Vts = (LAS bf16_t*)(lds + 34816);
    LAS bf16_t* Ps = (LAS bf16_t*)(lds + 71680);
    LAS float* es = (LAS float*)(lds + 80896);
    LAS float* Mt = (LAS float*)(lds + 81920); LAS float* inter = (LAS float*)(lds + 82176); LAS float* dfl = (LAS float*)(lds + 82432);
    LAS float* nqi = (LAS float*)(lds + 82688); LAS float* dinv = (LAS float*)(lds + 82944); LAS float* rinv = (LAS float*)(lds + 83200);
    LAS float* rs2 = (LAS float*)(lds + 83456);
    LAS float* ssq = (LAS float*)(lds + 83968);
    const bf16_t* QC = (const bf16_t*)(p.ws + WS_QC); const bf16_t* KC = (const bf16_t*)(p.ws + WS_KC); const bf16_t* VT = (const bf16_t*)(p.ws + WS_VT);
    const float* EG = (const float*)(p.ws + WS_EG); const float* BG = (const float*)(p.ws + WS_BG);
    { const int t = tid >> 3, part = tid & 7; const bf16_t* src = QC + ((size_t)bh * 4352 + J * 256 + tb * 64 + t) * 128 + part * 16;
      *(LAS u32x4*)(Qs + t * 136 + part * 16) = *(const u32x4*)src; *(LAS u32x4*)(Qs + t * 136 + part * 16 + 8) = *(const u32x4*)(src + 8); }
    f32x4 H[4][2];
#pragma unroll
    for (int a = 0; a < 4; ++a) { H[a][0] = (f32x4){0.f, 0.f, 0.f, 0.f}; H[a][1] = (f32x4){0.f, 0.f, 0.f, 0.f}; }
#pragma unroll 1
    for (int dir = 0; dir < 2; ++dir) {
        const int chain = bh * 2 + dir, sidx = chain * 17 + J;
        const float m_in = ((const float*)(p.ws + WS_MIN))[sidx];
        const int sb_lo = dir == 0 ? 0 : tb, sb_hi = dir == 0 ? tb : 3;
        u32x4 kr[2], vr[4];
#define M3_LOADKV(sbx) do { const bf16_t* ksrc = KC + ((size_t)bh * 4352 + J * 256 + (sbx) * 64 + (tid >> 3)) * 128 + (tid & 7) * 16; kr[0] = *(const u32x4*)ksrc; kr[1] = *(const u32x4*)(ksrc + 8); \
        const bf16_t* vsrc = VT + ((((size_t)bh * 17 + J) * 4 + (sbx)) * 256 + (tid >> 1)) * 64 + (tid & 1) * 32; vr[0] = *(const u32x4*)vsrc; vr[1] = *(const u32x4*)(vsrc + 8); vr[2] = *(const u32x4*)(vsrc + 16); vr[3] = *(const u32x4*)(vsrc + 24); } while (0)
        M3_LOADKV(sb_lo);
        if (tid < 256) es[tid] = EG[(size_t)chain * 4352 + J * 256 + tid];
        float bgv = 0.f; if (tid < 64) bgv = BG[(size_t)chain * 4352 + J * 256 + tb * 64 + tid];
        float4 nv[4]; { const float* nin = (const float*)(p.ws + WS_NIN) + (size_t)sidx * 128 + (tid & 7) * 16;
#pragma unroll
            for (int i = 0; i < 4; ++i) nv[i] = *(const float4*)(nin + 4 * i); }
        __syncthreads();
        if (tid < 64) { const int T = tb * 64 + tid; float v = es[T], oth = -3e38f;
            if (dir == 0) {
#pragma unroll
                for (int o = 1; o < 64; o <<= 1) { const float t2 = __shfl_up(v, o); if (lane >= o) v = fmaxf(v, t2); }
                for (int k = 0; k < tb; ++k) oth = fmaxf(oth, es[k * 64 + lane]);
            } else {
#pragma unroll
                for (int o = 1; o < 64; o <<= 1) { const float t2 = __shfl_down(v, o); if (lane + o < 64) v = fmaxf(v, t2); }
                for (int k = tb + 1; k < 4; ++k) oth = fmaxf(oth, es[k * 64 + lane]);
            }
#pragma unroll
            for (int o = 32; o; o >>= 1) oth = fmaxf(oth, shx(oth, o));
            const float pm = fmaxf(v, oth);
            const float M = fmaxf(m_in, pm); Mt[tid] = M; inter[tid] = __expf(m_in - M);
            dfl[tid] = __expf(-(bgv + M)); }
        { const int t = tid >> 3, part = tid & 7; float s = 0.f;
#pragma unroll
          for (int i = 0; i < 4; ++i) { const u32x2 qw = *(LAS u32x2*)(Qs + t * 136 + part * 16 + 4 * i);
              s += bflo(qw.x) * nv[i].x + bfhi(qw.x) * nv[i].y + bflo(qw.y) * nv[i].z + bfhi(qw.y) * nv[i].w; }
          s += shx(s, 1); s += shx(s, 2); s += shx(s, 4); if (part == 0) nqi[t] = s; }
        __syncthreads();
        f32x4 O[4][2];
#pragma unroll
        for (int a = 0; a < 4; ++a) { O[a][0] = (f32x4){0.f, 0.f, 0.f, 0.f}; O[a][1] = (f32x4){0.f, 0.f, 0.f, 0.f}; }
        { const bf16_t* Cg = (const bf16_t*)(p.ws + WS_CIN) + (size_t)sidx * 32768;
#pragma unroll
          for (int ks = 0; ks < 4; ++ks) { bf16x8 Bf[2];
#pragma unroll
              for (int nt = 0; nt < 2; ++nt) Bf[nt] = *(const bf16x8*)(Cg + (size_t)(32 * wid + 16 * nt + r) * 128 + 32 * ks + 8 * q);
#pragma unroll
              for (int mt = 0; mt < 4; ++mt) { const bf16x8 A = *(LAS bf16x8*)(Qs + (16 * mt + r) * 136 + 32 * ks + 8 * q); O[mt][0] = MFMA16(Bf[0], A, O[mt][0]); O[mt][1] = MFMA16(Bf[1], A, O[mt][1]); } }
#pragma unroll
          for (int mt = 0; mt < 4; ++mt) { const float it = inter[16 * mt + r]; O[mt][0] *= it; O[mt][1] *= it; } }
        float rsum[4] = {0.f, 0.f, 0.f, 0.f};
#pragma unroll 1
        for (int sb = sb_lo; sb <= sb_hi; ++sb) {
            { const int t = tid >> 3, part = tid & 7; *(LAS u32x4*)(Ks + t * 136 + part * 16) = kr[0]; *(LAS u32x4*)(Ks + t * 136 + part * 16 + 8) = kr[1]; }
            { const int v = tid >> 1, half = tid & 1;
#pragma unroll
              for (int i = 0; i < 4; ++i) *(LAS u32x4*)(Vts + v * 72 + half * 32 + 8 * i) = vr[i]; }
            __syncthreads();
            if (sb < sb_hi) M3_LOADKV(sb + 1);
            { const int mt = wid & 3, ntb = (wid >> 2) * 2; f32x4 S[2]; S[0] = (f32x4){0.f, 0.f, 0.f, 0.f}; S[1] = S[0];
#pragma unroll
              for (int ks = 0; ks < 4; ++ks) { const bf16x8 A = *(LAS bf16x8*)(Qs + (16 * mt + r) * 136 + 32 * ks + 8 * q);
#pragma unroll
                  for (int n2 = 0; n2 < 2; ++n2) { const bf16x8 B = *(LAS bf16x8*)(Ks + (16 * (ntb + n2) + r) * 136 + 32 * ks + 8 * q); S[n2] = MFMA16(A, B, S[n2]); } }
#pragma unroll
              for (int n2 = 0; n2 < 2; ++n2)
#pragma unroll
                  for (int j = 0; j < 4; ++j) { const int t = 16 * mt + 4 * q + j, s = 16 * (ntb + n2) + r, Tg = tb * 64 + t, Sg = sb * 64 + s;
                      const bool ok = dir == 0 ? (Sg <= Tg) : (Sg >= Tg);
                      const float pv = ok ? S[n2][j] * __expf(fminf(es[Sg] - Mt[t], 0.f)) : 0.f;
                      rsum[j] += pv; Ps[t * 72 + s] = (bf16_t)f2bf(pv); } }
            __syncthreads();
#pragma unroll
            for (int ks = 0; ks < 2; ++ks) { bf16x8 Bf[2];
#pragma unroll
                for (int nt = 0; nt < 2; ++nt) Bf[nt] = *(LAS bf16x8*)(Vts + (32 * wid + 16 * nt + r) * 72 + 32 * ks + 8 * q);
#pragma unroll
                for (int mt = 0; mt < 4; ++mt) { const bf16x8 A = *(LAS bf16x8*)(Ps + (16 * mt + r) * 72 + 32 * ks + 8 * q); O[mt][0] = MFMA16(Bf[0], A, O[mt][0]); O[mt][1] = MFMA16(Bf[1], A, O[mt][1]); } }
            __syncthreads();
        }
#pragma unroll
        for (int j = 0; j < 4; ++j) { float v = rsum[j]; v += shx(v, 1); v += shx(v, 2); v += shx(v, 4); v += shx(v, 8);
            if (r == 0) rs2[(16 * (wid & 3) + 4 * q + j) * 2 + (wid >> 2)] = v; }
        __syncthreads();
        if (tid < 64) { const float nq = inter[tid] * nqi[tid] + rs2[2 * tid] + rs2[2 * tid + 1]; dinv[tid] = 1.f / fmaxf(fabsf(nq), dfl[tid]); }
        __syncthreads();
#pragma unroll
        for (int mt = 0; mt < 4; ++mt) { const float di = dinv[16 * mt + r]; H[mt][0] += O[mt][0] * di; H[mt][1] += O[mt][1] * di; }
        __syncthreads();
    }
#pragma unroll
    for (int mt = 0; mt < 4; ++mt) { float v = 0.f;
#pragma unroll
        for (int j = 0; j < 4; ++j) v += H[mt][0][j] * H[mt][0][j] + H[mt][1][j] * H[mt][1][j];
        v += shx(v, 16); v += shx(v, 32);
        if (q == 0) ssq[(16 * mt + r) * 8 + wid] = v; }
    __syncthreads();
    if (tid < 64) { float s = 0.f;
#pragma unroll
        for (int w = 0; w < 8; ++w) s += ssq[tid * 8 + w];
        rinv[tid] = rsqrtf(s * (1.f / 256.f) + 1e-6f); }
    __syncthreads();
    const bf16_t* P = (const bf16_t*)(p.ws + WS_P); bf16_t* Y = (bf16_t*)(p.ws + WS_Y);
#pragma unroll
    for (int mt = 0; mt < 4; ++mt) { const int t = 16 * mt + r; const size_t row = (size_t)pos_row(b, J * 256 + tb * 64 + t); const float ri = rinv[t];
#pragma unroll
        for (int nt = 0; nt < 2; ++nt) { const int col = h * 256 + 32 * wid + 16 * nt + 4 * q;
            const u32x2 ow = *(const u32x2*)(P + row * NPC + 2048 + col), zw = *(const u32x2*)(P + row * NPC + 3072 + col); const float4 gn = *(const float4*)(p.mng + l * 1024 + col);
            const float o0 = bflo(ow.x), o1 = bfhi(ow.x), o2 = bflo(ow.y), o3 = bfhi(ow.y), z0 = bflo(zw.x), z1 = bfhi(zw.x), z2 = bflo(zw.y), z3 = bfhi(zw.y);
            u32x2 yw; yw.x = pk2(H[mt][nt][0] * ri * gn.x * sigm(o0) * z0 * sigm(z0), H[mt][nt][1] * ri * gn.y * sigm(o1) * z1 * sigm(z1));
            yw.y = pk2(H[mt][nt][2] * ri * gn.z * sigm(o2) * z2 * sigm(z2), H[mt][nt][3] * ri * gn.w * sigm(o3) * z3 * sigm(z3));
            *(u32x2*)(Y + row * 2048 + col) = yw; } }
    __syncthreads();
}

DI void r_task(LAS unsigned char* lds, const Params& p, int l, int task, int mode, const int d0 = 0, const int d1 = 2) {
    const int g = task & 15, seg = task >> 4;
    const int tid = ltid(), wid = tid >> 6, lane = tid & 63, r = lane & 15, q = lane >> 4;
    int b, base_row, tok0, seqlen, s16 = 0;
    if (seg < 2) { b = seg; base_row = 8192 + b * 256; tok0 = 0; seqlen = 256; } else { const int si = seg - 2; b = si >> 4; s16 = si & 15; base_row = b * 4096; tok0 = s16 * 256; seqlen = 4096; }
    LAS float* xcf = (LAS float*)lds;
    LAS bf16_t* xcb = (LAS bf16_t*)(lds + 66560);
    LAS float* wagg = (LAS float*)(lds + 103424);
    LAS float* hin = (LAS float*)(lds + 107520);
    const bf16_t* P = (const bf16_t*)(p.ws + WS_P);
    if (mode == 0) { const int t = tid & 255, half = __builtin_amdgcn_readfirstlane(tid >> 8), cb = 64 * g + half * 32;
      float a[32];
#pragma unroll
      for (int i = 0; i < 32; i += 4) { const float4 bb = *(const float4*)(p.crb + l * 1024 + cb + i); a[i] = bb.x; a[i + 1] = bb.y; a[i + 2] = bb.z; a[i + 3] = bb.w; }
#pragma unroll
      for (int j = 0; j < 4; ++j) { const int tk = tok0 + t - 1 + j;
          if (tk >= 0 && tk < seqlen) { const bf16_t* src = P + (size_t)(base_row + tk) * NPC + 4096 + cb; const float* wp = p.crw + (size_t)(l * 4 + j) * 1024 + cb;
#pragma unroll
              for (int i8 = 0; i8 < 4; ++i8) { const u32x4 w = *(const u32x4*)(src + 8 * i8); const float4 w0 = *(const float4*)(wp + 8 * i8), w1 = *(const float4*)(wp + 8 * i8 + 4);
                  a[8 * i8 + 0] += w0.x * bflo(w.x); a[8 * i8 + 1] += w0.y * bfhi(w.x); a[8 * i8 + 2] += w0.z * bflo(w.y); a[8 * i8 + 3] += w0.w * bfhi(w.y);
                  a[8 * i8 + 4] += w1.x * bflo(w.z); a[8 * i8 + 5] += w1.y * bfhi(w.z); a[8 * i8 + 6] += w1.z * bflo(w.w); a[8 * i8 + 7] += w1.w * bfhi(w.w); } } }
#pragma unroll
      for (int i = 0; i < 32; ++i) xcf[t * 65 + half * 32 + i] = a[i];
#pragma unroll
      for (int i8 = 0; i8 < 4; ++i8) { u32x4 w; w.x = pk2(a[8 * i8], a[8 * i8 + 1]); w.y = pk2(a[8 * i8 + 2], a[8 * i8 + 3]); w.z = pk2(a[8 * i8 + 4], a[8 * i8 + 5]); w.w = pk2(a[8 * i8 + 6], a[8 * i8 + 7]);
          *(LAS u32x4*)(xcb + t * 72 + half * 32 + 8 * i8) = w; } }
    __syncthreads();
    f32x4 Hs[2][4];
#pragma unroll
    for (int a = 0; a < 2; ++a)
#pragma unroll
        for (int n = 0; n < 4; ++n) Hs[a][n] = (f32x4){0.f, 0.f, 0.f, 0.f};
    const float2* RA = (const float2*)(p.ws + WS_RAGG);
#pragma unroll 1
    for (int dir = d0; dir < d1; ++dir) {
        if (mode == 1 && tid < 64) { float hh = 0.f;
            if (seg >= 2) { float2 au[17]; au[0] = RA[((size_t)b * 2 + dir) * 1024 + 64 * g + tid];
#pragma unroll
                for (int k = 0; k < 16; ++k) { const int sk = dir == 0 ? k : 15 - k; const bool use = dir == 0 ? (sk < s16) : (sk > s16);
                    au[1 + k] = use ? RA[((size_t)(2 + b * 16 + sk) * 2 + dir) * 1024 + 64 * g + tid] : make_float2(1.f, 0.f); }
#pragma unroll
                for (int k = 0; k < 17; ++k) hh = au[k].x * hh + au[k].y; }
            hin[tid] = hh; }
        const bf16_t* Wr = (const bf16_t*)(p.ws + WS_WRT) + ((size_t)((l * 2 + dir) * 2 + 0) * 16 + g) * 4096; const bf16_t* Wi = Wr + (size_t)16 * 4096;
        unsigned* LU = (unsigned*)(p.ws + WS_LU) + ((size_t)dir * NTOK + base_row + tok0) * 1024 + 64 * g;
        f32x4 R[2][4], I[2][4];
        if (mode == 1) {
#pragma unroll
            for (int mt = 0; mt < 2; ++mt)
#pragma unroll
                for (int nt = 0; nt < 4; ++nt)
#pragma unroll
                    for (int j = 0; j < 4; ++j) { const unsigned w = LU[(size_t)(32 * wid + 16 * mt + 4 * q + j) * 1024 + 16 * nt + r]; R[mt][nt][j] = __builtin_amdgcn_exp2f(bflo(w)); I[mt][nt][j] = bfhi(w); }
        } else {
#pragma unroll
        for (int a = 0; a < 2; ++a)
#pragma unroll
            for (int n = 0; n < 4; ++n) { R[a][n] = (f32x4){0.f, 0.f, 0.f, 0.f}; I[a][n] = (f32x4){0.f, 0.f, 0.f, 0.f}; }
#pragma unroll
        for (int ks = 0; ks < 2; ++ks) { bf16x8 A[2];
#pragma unroll
            for (int mt = 0; mt < 2; ++mt) A[mt] = *(LAS bf16x8*)(xcb + (32 * wid + 16 * mt + r) * 72 + 32 * ks + 8 * q);
#pragma unroll
            for (int nt = 0; nt < 4; ++nt) { const bf16x8 br = *(const bf16x8*)(Wr + (16 * nt + r) * 64 + 32 * ks + 8 * q), bi = *(const bf16x8*)(Wi + (16 * nt + r) * 64 + 32 * ks + 8 * q);
                R[0][nt] = MFMA16(A[0], br, R[0][nt]); R[1][nt] = MFMA16(A[1], br, R[1][nt]); I[0][nt] = MFMA16(A[0], bi, I[0][nt]); I[1][nt] = MFMA16(A[1], bi, I[1][nt]); } }
#pragma unroll
        for (int nt = 0; nt < 4; ++nt) { const int ch = 64 * g + 16 * nt + r;
            const float br = p.b_rg[(size_t)((l * 2 + dir) * 2 + 0) * 1024 + ch], bi = p.b_rg[(size_t)((l * 2 + dir) * 2 + 1) * 1024 + ch], lm = p.lam[(size_t)(l * 2 + dir) * 1024 + ch];
            const float sp = fmaxf(-lm, 0.f) + __logf(1.f + __expf(-fabsf(lm)));
            const float nbr = -1.4426950408889634f * br, nbi = -1.4426950408889634f * bi, c2 = -8.f * 1.4426950408889634f * sp, ct = 16.f * sp;
#pragma unroll
            for (int mt = 0; mt < 2; ++mt)
#pragma unroll
                for (int j = 0; j < 4; ++j) { const int t = 32 * wid + 16 * mt + 4 * q + j;
                    const float d1 = 1.f + __builtin_amdgcn_exp2f(fminf(__builtin_fmaf(R[mt][nt][j], -1.4426950408889634f, nbr), 43.f));
                    const float d2 = 1.f + __builtin_amdgcn_exp2f(fminf(__builtin_fmaf(I[mt][nt][j], -1.4426950408889634f, nbi), 43.f));
                    const float rc = __builtin_amdgcn_rcpf(d1 * d2), rr = d2 * rc, ii = d1 * rc, la2 = rr * c2, a = __builtin_amdgcn_exp2f(la2), tt = rr * ct;
                    const float om = tt < 1e-3f ? tt * (1.f - 0.5f * tt) : __builtin_fmaf(-a, a, 1.f);
                    const float uu = __builtin_amdgcn_sqrtf(om) * ii * xcf[t * 65 + 16 * nt + r];
                    R[mt][nt][j] = a; I[mt][nt][j] = uu; LU[(size_t)t * 1024 + 16 * nt + r] = pk2(la2, uu); } }
        }
        float pA[2][4], pU[2][4], tA[2][4], tU[2][4];
#pragma unroll
        for (int mt = 0; mt < 2; ++mt)
#pragma unroll
            for (int nt = 0; nt < 4; ++nt) { const f32x4 a = R[mt][nt], u = I[mt][nt]; float A_, U_;
                if (dir == 0) { A_ = a[0] * a[1] * a[2] * a[3]; U_ = ((u[0] * a[1] + u[1]) * a[2] + u[2]) * a[3] + u[3]; }
                else { A_ = a[0] * a[1] * a[2] * a[3]; U_ = ((u[3] * a[2] + u[2]) * a[1] + u[1]) * a[0] + u[0]; }
                float Ak[4], Uk[4];
#pragma unroll
                for (int k = 0; k < 4; ++k) { Ak[k] = __shfl(A_, r + 16 * k); Uk[k] = __shfl(U_, r + 16 * k); }
                float PA = 1.f, PU = 0.f, TA = 1.f, TU = 0.f;
                if (dir == 0) {
#pragma unroll
                    for (int k = 0; k < 4; ++k) { if (k < q) { PU = PU * Ak[k] + Uk[k]; PA *= Ak[k]; } TU = TU * Ak[k] + Uk[k]; TA *= Ak[k]; }
                } else {
#pragma unroll
                    for (int k = 3; k >= 0; --k) { if (k > q) { PU = PU * Ak[k] + Uk[k]; PA *= Ak[k]; } TU = TU * Ak[k] + Uk[k]; TA *= Ak[k]; }
                }
                pA[mt][nt] = PA; pU[mt][nt] = PU; tA[mt][nt] = TA; tU[mt][nt] = TU; }
#pragma unroll
        for (int nt = 0; nt < 4; ++nt) {
            const float WA = tA[0][nt] * tA[1][nt], WU = dir == 0 ? tU[0][nt] * tA[1][nt] + tU[1][nt] : tU[1][nt] * tA[0][nt] + tU[0][nt];
            if (q == 0) { wagg[(wid * 2 + 0) * 64 + 16 * nt + r] = WA; wagg[(wid * 2 + 1) * 64 + 16 * nt + r] = WU; } }
        __syncthreads();
        if (mode == 0) {
            if (tid < 64) { float A_ = 1.f, U_ = 0.f;
#pragma unroll
                for (int kk = 0; kk < 8; ++kk) { const int w = dir == 0 ? kk : 7 - kk; const float a = wagg[(w * 2 + 0) * 64 + tid], u = wagg[(w * 2 + 1) * 64 + tid]; U_ = U_ * a + u; A_ *= a; }
                ((float2*)(p.ws + WS_RAGG))[((size_t)seg * 2 + dir) * 1024 + 64 * g + tid] = make_float2(A_, U_); }
        } else {
#pragma unroll
            for (int nt = 0; nt < 4; ++nt) { float hh = hin[16 * nt + r];
                if (dir == 0) { for (int w = 0; w < wid; ++w) hh = wagg[(w * 2 + 0) * 64 + 16 * nt + r] * hh + wagg[(w * 2 + 1) * 64 + 16 * nt + r]; }
                else { for (int w = 7; w > wid; --w) hh = wagg[(w * 2 + 0) * 64 + 16 * nt + r] * hh + wagg[(w * 2 + 1) * 64 + 16 * nt + r]; }
                if (dir == 0) {
#pragma unroll
                    for (int mt = 0; mt < 2; ++mt) { float hv = pA[mt][nt] * hh + pU[mt][nt];
#pragma unroll
                        for (int j = 0; j < 4; ++j) { hv = R[mt][nt][j] * hv + I[mt][nt][j]; Hs[mt][nt][j] += hv; }
                        hh = tA[mt][nt] * hh + tU[mt][nt]; }
                } else {
#pragma unroll
                    for (int mt = 1; mt >= 0; --mt) { float hv = pA[mt][nt] * hh + pU[mt][nt];
#pragma unroll
                        for (int j = 3; j >= 0; --j) { hv = R[mt][nt][j] * hv + I[mt][nt][j]; Hs[mt][nt][j] += hv; }
                        hh = tA[mt][nt] * hh + tU[mt][nt]; }
                } }
        }
        __syncthreads();
    }
    if (mode == 1) { bf16_t* Y = (bf16_t*)(p.ws + WS_Y);
#pragma unroll
        for (int mt = 0; mt < 2; ++mt)
#pragma unroll
            for (int nt = 0; nt < 4; ++nt)
#pragma unroll
                for (int j = 0; j < 4; ++j) { const size_t row = (size_t)(base_row + tok0 + 32 * wid + 16 * mt + 4 * q + j); const int ch = 64 * g + 16 * nt + r;
                    const float z = bf2f(P[row * NPC + 5120 + ch]); Y[row * 2048 + 1024 + ch] = (bf16_t)f2bf(Hs[mt][nt][j] * z * sigm(z)); } }
    __syncthreads();
}

#if SINGLE_LAUNCH

DI void r0s_task(LAS unsigned char* lds, const Params& p, int l, int task) {
    const int g = task & 15, seg = task >> 4;
    const int tid = ltid(), wid = tid >> 6, lane = tid & 63, r = lane & 15, q = lane >> 4;
    int b, base_row, tok0, seqlen;
    if (seg < 2) { b = seg; base_row = 8192 + b * 256; tok0 = 0; seqlen = 256; } else { const int si = seg - 2; b = si >> 4; base_row = b * 4096; tok0 = (si & 15) * 256; seqlen = 4096; }
    LAS float* xcf = (LAS float*)lds;
    LAS bf16_t* GR = (LAS bf16_t*)(lds + 69632);
    LAS bf16_t* GI = (LAS bf16_t*)(lds + 69632 + 32768);
    LAS float* agg = (LAS float*)(lds + 69632 + 65536);
    const bf16_t* P = (const bf16_t*)(p.ws + WS_P);
    { const int t = tid >> 1, half = tid & 1, cb = 64 * g + half * 32;
      float a[32];
#pragma unroll
      for (int i = 0; i < 32; i += 4) { const float4 bb = *(const float4*)(p.crb + l * 1024 + cb + i); a[i] = bb.x; a[i + 1] = bb.y; a[i + 2] = bb.z; a[i + 3] = bb.w; }
#pragma unroll
      for (int j = 0; j < 4; ++j) { const int tk = tok0 + t - 1 + j;
          if (tk >= 0 && tk < seqlen) { const bf16_t* src = P + (size_t)(base_row + tk) * NPC + 4096 + cb; const float* wp = p.crw + (size_t)(l * 4 + j) * 1024 + cb;
#pragma unroll
              for (int i8 = 0; i8 < 4; ++i8) { const u32x4 w = *(const u32x4*)(src + 8 * i8); const float4 w0 = *(const float4*)(wp + 8 * i8), w1 = *(const float4*)(wp + 8 * i8 + 4);
                  a[8 * i8 + 0] += w0.x * bflo(w.x); a[8 * i8 + 1] += w0.y * bfhi(w.x); a[8 * i8 + 2] += w0.z * bflo(w.y); a[8 * i8 + 3] += w0.w * bfhi(w.y);
                  a[8 * i8 + 4] += w1.x * bflo(w.z); a[8 * i8 + 5] += w1.y * bfhi(w.z); a[8 * i8 + 6] += w1.z * bflo(w.w); a[8 * i8 + 7] += w1.w * bfhi(w.w); } } }
#pragma unroll
      for (int i = 0; i < 32; i += 4) *(LAS f32x4*)(xcf + t * 68 + half * 32 + i) = (f32x4){a[i], a[i + 1], a[i + 2], a[i + 3]}; }
    __syncthreads();
    bf16x8 Af[2][2];
#pragma unroll
    for (int ks = 0; ks < 2; ++ks)
#pragma unroll
        for (int mt = 0; mt < 2; ++mt) { const LAS float* src = xcf + (32 * wid + 16 * mt + r) * 68 + 32 * ks + 8 * q; const f32x4 x0 = *(const LAS f32x4*)src, x1 = *(const LAS f32x4*)(src + 4);
            u32x4 w; w.x = pk2(x0[0], x0[1]); w.y = pk2(x0[2], x0[3]); w.z = pk2(x1[0], x1[1]); w.w = pk2(x1[2], x1[3]); Af[ks][mt] = __builtin_bit_cast(bf16x8, w); }
#pragma unroll 1
    for (int dir = 0; dir < 2; ++dir) {
        const bf16_t* Wr = (const bf16_t*)(p.ws + WS_WRT) + ((size_t)((l * 2 + dir) * 2 + 0) * 16 + g) * 4096; const bf16_t* Wi = Wr + (size_t)16 * 4096;
        { f32x4 R[2][4], I[2][4];
#pragma unroll
          for (int a = 0; a < 2; ++a)
#pragma unroll
              for (int n = 0; n < 4; ++n) { R[a][n] = (f32x4){0.f, 0.f, 0.f, 0.f}; I[a][n] = (f32x4){0.f, 0.f, 0.f, 0.f}; }
#pragma unroll
          for (int ks = 0; ks < 2; ++ks)
#pragma unroll
              for (int nt = 0; nt < 4; ++nt) { const bf16x8 br = *(const bf16x8*)(Wr + (16 * nt + r) * 64 + 32 * ks + 8 * q), bi = *(const bf16x8*)(Wi + (16 * nt + r) * 64 + 32 * ks + 8 * q);
                  R[0][nt] = MFMA16(Af[ks][0], br, R[0][nt]); R[1][nt] = MFMA16(Af[ks][1], br, R[1][nt]); I[0][nt] = MFMA16(Af[ks][0], bi, I[0][nt]); I[1][nt] = MFMA16(Af[ks][1], bi, I[1][nt]); }
#pragma unroll
          for (int mt = 0; mt < 2; ++mt)
#pragma unroll
              for (int nt = 0; nt < 4; ++nt)
#pragma unroll
                  for (int j = 0; j < 4; ++j) { const int o = (32 * wid + 16 * mt + 4 * q + j) * 64 + 16 * nt + r; GR[o] = (bf16_t)f2bf(R[mt][nt][j]); GI[o] = (bf16_t)f2bf(I[mt][nt][j]); } }
        __syncthreads();
        { const int c = lane, ch = 64 * g + c;
          const float br = p.b_rg[(size_t)((l * 2 + dir) * 2 + 0) * 1024 + ch], bi = p.b_rg[(size_t)((l * 2 + dir) * 2 + 1) * 1024 + ch], lm = p.lam[(size_t)(l * 2 + dir) * 1024 + ch];
          const float sp = fmaxf(-lm, 0.f) + __logf(1.f + __expf(-fabsf(lm)));
          unsigned* LU = (unsigned*)(p.ws + WS_LU) + ((size_t)dir * NTOK + base_row + tok0) * 1024 + ch;
          float Aa = 1.f, Uu = 0.f;
#pragma unroll 4
          for (int i = 0; i < 32; ++i) { const int t = 32 * wid + (dir == 0 ? i : 31 - i);
              const float d1 = 1.f + __expf(-fmaxf(bf2f(GR[t * 64 + c]) + br, -30.f)), d2 = 1.f + __expf(-fmaxf(bf2f(GI[t * 64 + c]) + bi, -30.f)), rc = __builtin_amdgcn_rcpf(d1 * d2);
              const float rr = d2 * rc, ii = d1 * rc, la = -8.f * rr * sp, a = __expf(la);
              const float uu = __builtin_amdgcn_sqrtf(one_m_expneg(-2.f * la, a * a)) * ii * xcf[t * 68 + c];
              LU[(size_t)t * 1024] = pk2(la, uu);
              Uu = Uu * a + uu; Aa *= a; }
          agg[(wid * 2 + 0) * 64 + c] = Aa; agg[(wid * 2 + 1) * 64 + c] = Uu; }
        __syncthreads();
        if (tid < 64) { float A_ = 1.f, U_ = 0.f;
#pragma unroll
            for (int kk = 0; kk < 8; ++kk) { const int w = dir == 0 ? kk : 7 - kk; const float a = agg[(w * 2 + 0) * 64 + tid], u = agg[(w * 2 + 1) * 64 + tid]; U_ = U_ * a + u; A_ *= a; }
            ((float2*)(p.ws + WS_RAGG))[((size_t)seg * 2 + dir) * 1024 + 64 * g + tid] = make_float2(A_, U_); }
        __syncthreads();
    }
}

DI void rs_task(LAS unsigned char* lds, const Params& p, int l, int task) {
    const int cg4 = task & 3, seg = task >> 2;
    const int tid = ltid();
    int b, base_row, tok0, s16 = 0;
    if (seg < 2) { b = seg; base_row = 8192 + b * 256; tok0 = 0; } else { const int si = seg - 2; b = si >> 4; s16 = si & 15; base_row = b * 4096; tok0 = s16 * 256; }
    LAS bf16_t* Hs = (LAS bf16_t*)lds;
    const int c = tid & 255, dir = tid >> 8, ch = 256 * cg4 + c;
    float h = 0.f;
    { const float2* RA = (const float2*)(p.ws + WS_RAGG);
      if (seg >= 2) { float2 au[17]; au[0] = RA[((size_t)b * 2 + dir) * 1024 + ch];
#pragma unroll
          for (int k = 0; k < 16; ++k) { const int sk = dir == 0 ? k : 15 - k; const bool use = dir == 0 ? (sk < s16) : (sk > s16);
              au[1 + k] = use ? RA[((size_t)(2 + b * 16 + sk) * 2 + dir) * 1024 + ch] : make_float2(1.f, 0.f); }
#pragma unroll
          for (int k = 0; k < 17; ++k) h = au[k].x * h + au[k].y; } }
    const unsigned* LU = (const unsigned*)(p.ws + WS_LU) + ((size_t)dir * NTOK + base_row + tok0) * 1024 + ch;
    LAS bf16_t* Hd = Hs + c;
    unsigned wa[32], wb[32];
#define RS_LOAD(dst, s0) _Pragma("unroll") for (int i = 0; i < 32; ++i) { const int t = dir == 0 ? (s0) + i : 255 - (s0) - i; dst[i] = LU[(size_t)t * 1024]; }
#define RS_SCAN(src, s0, ADD) _Pragma("unroll") for (int i = 0; i < 32; ++i) { const int t = dir == 0 ? (s0) + i : 255 - (s0) - i; h = __builtin_amdgcn_exp2f(bflo(src[i])) * h + bfhi(src[i]); \
        const float o_ = ADD ? h + bf2f(Hd[t * 256]) : h; Hd[t * 256] = (bf16_t)f2bf(o_); }
    RS_LOAD(wa, 0)
#pragma unroll 1
    for (int s0 = 0; s0 < 128; s0 += 64) { RS_LOAD(wb, s0 + 32) RS_SCAN(wa, s0, false) RS_LOAD(wa, s0 + 64) RS_SCAN(wb, s0 + 32, false) }
    __syncthreads();
#pragma unroll 1
    for (int s0 = 128; s0 < 256; s0 += 64) { RS_LOAD(wb, s0 + 32) RS_SCAN(wa, s0, true) if (s0 + 64 < 256) { RS_LOAD(wa, s0 + 64) } RS_SCAN(wb, s0 + 32, true) }
    __syncthreads();
    const bf16_t* P = (const bf16_t*)(p.ws + WS_P); bf16_t* Y = (bf16_t*)(p.ws + WS_Y);
#pragma unroll 2
    for (int i = 0; i < 16; ++i) { const int chunk = tid + 512 * i, t = chunk >> 5, c8 = (chunk & 31) * 8; const size_t row = (size_t)(base_row + tok0 + t);
        const u32x4 hh = *(LAS u32x4*)(Hs + t * 256 + c8), zz = *(const u32x4*)(P + row * NPC + 5120 + 256 * cg4 + c8);
        u32x4 o;
        { const float z0 = bflo(zz.x), z1 = bfhi(zz.x); o.x = pk2(bflo(hh.x) * z0 * sigm(z0), bfhi(hh.x) * z1 * sigm(z1)); }
        { const float z0 = bflo(zz.y), z1 = bfhi(zz.y); o.y = pk2(bflo(hh.y) * z0 * sigm(z0), bfhi(hh.y) * z1 * sigm(z1)); }
        { const float z0 = bflo(zz.z), z1 = bfhi(zz.z); o.z = pk2(bflo(hh.z) * z0 * sigm(z0), bfhi(hh.z) * z1 * sigm(z1)); }
        { const float z0 = bflo(zz.w), z1 = bfhi(zz.w); o.w = pk2(bflo(hh.w) * z0 * sigm(z0), bfhi(hh.w) * z1 * sigm(z1)); }
        *(u32x4*)(Y + row * 2048 + 1024 + 256 * cg4 + c8) = o; }
    __syncthreads();
}

__device__ unsigned g_q[32 * 64];
DI int next_chunk(LAS unsigned char* lds, int qi, unsigned n) { asm volatile("" : "+s"(qi)); LAS int* slot = (LAS int*)(lds + LDS_BYTES - 64); if (ltid() == 0) *slot = (int)__hip_atomic_fetch_add(&g_q[qi * 64], n, __ATOMIC_RELAXED, __HIP_MEMORY_SCOPE_AGENT); __syncthreads(); return *slot; }
DI int next_task(LAS unsigned char* lds, int ph) { asm volatile("" : "+s"(ph)); LAS int* slot = (LAS int*)(lds + LDS_BYTES - 64); if (ltid() == 0) *slot = (int)gridDim.x + (int)__hip_atomic_fetch_add(&g_q[ph * 64], 1u, __ATOMIC_RELAXED, __HIP_MEMORY_SCOPE_AGENT); __syncthreads(); return *slot; }
#define XB_XCNT(j) (64 * (j))
#define XB_XSUB(j) (1024 + 64 * (j))
#define XB_XGEN(j) (2048 + 64 * (j))
#define XB_TOP 3072
#define XB_TOPGEN 3136
__device__ unsigned g_bar[3200];
DI unsigned xb_ld(unsigned* p) { return __hip_atomic_load(p, __ATOMIC_RELAXED, __HIP_MEMORY_SCOPE_AGENT); }
DI unsigned xb_add(unsigned* p, unsigned v) { return __hip_atomic_fetch_add(p, v, __ATOMIC_RELAXED, __HIP_MEMORY_SCOPE_AGENT); }
DI void xb_st(unsigned* p, unsigned v) { __hip_atomic_store(p, v, __ATOMIC_RELAXED, __HIP_MEMORY_SCOPE_AGENT); }
DI unsigned xb_xcc_id() { return (unsigned)__builtin_amdgcn_s_getreg((3 << 11) | 20) & 0xFu; }
#define XB_SPIN(cond) do { unsigned _sp = 0; while (cond) { __builtin_amdgcn_s_sleep(1); if (++_sp > (1u << 22)) break; } } while (0)
DI void grid_barrier_post() { if (ltid() == 0) { int z = 0; asm volatile("" : "+s"(z)); (void)xb_add(&g_bar[z + XB_XCNT(xb_xcc_id())], 1u); } }
DI void grid_barrier_clear_census() { if (lbid() == 0 && ltid() < 16) { int z = 0; asm volatile("" : "+s"(z)); xb_st(&g_bar[z + XB_XCNT(ltid())], 0u); } }
DI void grid_barrier(LAS unsigned char* lds) {
    asm volatile("s_waitcnt vmcnt(0)" ::: "memory");
    __syncthreads();
    if (ltid() == 0) {
        int z = 0; asm volatile("" : "+s"(z)); unsigned* bar = &g_bar[z];
        volatile LAS unsigned* st = (volatile LAS unsigned*)(lds + LDS_BYTES - 32);
        const unsigned x = xb_xcc_id(), G = gridDim.x;
        unsigned nloc = st[0], nx = st[1];
        if (nloc == 0u) {
            unsigned sum, cnt, mine, sp = 0u;
            for (;;) { sum = 0u; cnt = 0u; mine = 0u;
#pragma unroll
                for (unsigned j = 0; j < 16; ++j) { const unsigned c = xb_ld(&bar[XB_XCNT(j)]); sum += c; cnt += (c > 0u) ? 1u : 0u; mine = (j == x) ? c : mine; }
                if (sum == G) break;
                __builtin_amdgcn_s_sleep(1); if (++sp > (1u << 22)) break; }
            nloc = mine > 0u ? mine : 1u; nx = cnt > 0u ? cnt : 1u; st[0] = nloc; st[1] = nx; }
        const unsigned genx = xb_ld(&bar[XB_XGEN(x)]);
        const unsigned old = xb_add(&bar[XB_XSUB(x)], 1u);
        if (old + 1u == nloc) {
            xb_st(&bar[XB_XSUB(x)], 0u);
            __builtin_amdgcn_fence(__ATOMIC_RELEASE, "agent");
            asm volatile("s_waitcnt vmcnt(0)" ::: "memory");
            const unsigned gent = xb_ld(&bar[XB_TOPGEN]);
            const unsigned o2 = xb_add(&bar[XB_TOP], 1u);
            if (o2 + 1u == nx) { xb_st(&bar[XB_TOP], 0u); __builtin_amdgcn_fence(__ATOMIC_RELEASE, "agent"); asm volatile("s_waitcnt vmcnt(0)" ::: "memory"); xb_add(&bar[XB_TOPGEN], 1u); }
            else XB_SPIN(xb_ld(&bar[XB_TOPGEN]) == gent);
            __builtin_amdgcn_fence(__ATOMIC_ACQUIRE, "agent");
            xb_add(&bar[XB_XGEN(x)], 1u);
            asm volatile("s_waitcnt vmcnt(0)" ::: "memory");
        } else {
            XB_SPIN(xb_ld(&bar[XB_XGEN(x)]) == genx);
            __builtin_amdgcn_fence(__ATOMIC_ACQUIRE, "agent");
            asm volatile("s_waitcnt vmcnt(0)" ::: "memory");
        }
    }
    __syncthreads();
}

__global__ void __launch_bounds__(512) fwd_kernel(Params pp) {
    extern __shared__ __attribute__((aligned(16))) unsigned char lds_raw[];
    LAS unsigned char* lds = (LAS unsigned char*)lds_raw;
    if (pp.ph_hi > 1000) { cg::grid_group grid = cg::this_grid(); grid.sync(); }
    if (ltid() < 2) ((volatile LAS unsigned*)(lds + LDS_BYTES - 32))[ltid()] = 0u;
    __syncthreads();
    grid_barrier_post();
#pragma unroll 1
    for (int ph = pp.ph_lo; ph < pp.ph_hi; ++ph) {
        Params p = pp; { size_t zoff = 0; asm volatile("" : "+s"(zoff)); p.ws = pp.ws + zoff; }
        if (ph == 0) { if (lbid() == 0 && ltid() < 32) __hip_atomic_store(&g_q[ltid() * 64], 0u, __ATOMIC_RELAXED, __HIP_MEMORY_SCOPE_AGENT); for (int rep = 0; rep < REP_PREP; ++rep) phase_prep(lds, p); }
        else if (ph == NPHASE - 1) phase_final(p);
        else {
            int l = (ph - 1) / 6; const int sub = (ph - 1) % 6; asm volatile("" : "+s"(l));
            if (sub == 0) { for (int rep = 0; rep < REP_N; ++rep) phase_norm(p, l); }
            else if (sub == 1) {
                pg8::Gemm g{(const pg8::bf16_t*)(p.ws + WS_HX), (const pg8::bf16_t*)(p.ws + WS_WIN) + (size_t)l * NG1 * 2048, NTOK, NG1, 2048, 2048};
                pg8::StaticOrder S; S.init(NTOK, NG1, (int)gridDim.x, lbid());
                EpiIn E{(bf16_t*)(p.ws + WS_P), (float*)(p.ws + WS_GT)};
                for (int rep = 0; rep < REP_G1; ++rep) pg8::gemm_phase<EpiIn, pg8::StaticOrder>(lds, g, S, E);
                if (l < DEPTH - 1) {
                    __syncthreads();
                    for (int u = next_chunk(lds, 26 + l, 2u); u < T_WCONV; u = next_chunk(lds, 26 + l, 2u)) { wconv_task(lds, p, l + 1, u); if (u + 1 < T_WCONV) wconv_task(lds, p, l + 1, u + 1); }
                }
            } else if (sub == 2) {
                for (int t = lbid(); t < 272 + 480 + 128; t = next_task(lds, ph)) {
                    if (t < 272) { for (int rep = 0; rep < REP_M1; ++rep) m1_task(lds, p, l, t); }
                    else if (t < 752) { for (int rep = 0; rep < REP_R0; ++rep) r_task(lds, p, l, t - 272, 0); }
                    else { const int i = t - 752; if (i & 1) r_task(lds, p, l, 480 + (i >> 1), 0, 1, 2); else r_task(lds, p, l, 480 + (i >> 1), 0, 0, 1); } }
            } else if (sub == 3) { for (int rep = 0; rep < REP_M2; ++rep) phase_m2(p); }
            else if (sub == 4) {
                for (int t = lbid(); t < 544 + 136; t = next_task(lds, ph)) {
                    const bool last = (l == DEPTH - 1);
                    if (t >= 136) { const int mt3 = t - 136; if (last && ((mt3 >> 2) % 17) == 0) continue; for (int rep = 0; rep < REP_M3; ++rep) m3_task(lds, p, l, mt3); }
                    else { if (last && t < 8) continue; for (int rep = 0; rep < REP_R1; ++rep) rs_task(lds, p, l, t); } }
            } else {
                const int M = 8192;
                pg8::Gemm g{(const pg8::bf16_t*)(p.ws + WS_Y), (const pg8::bf16_t*)(p.ws + WS_WOUT) + (size_t)l * 2048 * 2048, M, 2048, 2048, 2048};
                pg8::StaticOrder S; S.init(M, 2048, (int)gridDim.x, lbid());
                EpiOut E{p, l};
                pg8::gemm_phase<EpiOut, pg8::StaticOrder>(lds, g, S, E);
                if (l < DEPTH - 1) { const int sid = (int)gridDim.x - 1 - lbid();
                    if (sid < 128) { const int kpart = sid & 7, unit = sid >> 3;
                        pg8::Gemm g2{(const pg8::bf16_t*)(p.ws + WS_Y) + kpart * 256, (const pg8::bf16_t*)(p.ws + WS_WOUT) + (size_t)l * 2048 * 2048 + kpart * 256, NTOK, 2048, 256, 2048};
                        OneUnit S2{32 + (unit >> 3), unit & 7};
                        EpiPart E2{(float*)(p.ws + WS_PART) + (size_t)kpart * 512 * 2048};
                        __syncthreads();
                        pg8::gemm_phase<EpiPart, OneUnit>(lds, g2, S2, E2); } }
            }
        }
        __syncthreads();
        if (ph + 1 < pp.ph_hi) { grid_barrier(lds); if (ph == pp.ph_lo + 1) grid_barrier_clear_census(); }
    }
}

#else
#define LDSDECL extern __shared__ __attribute__((aligned(16))) unsigned char lds_raw[]; LAS unsigned char* lds = (LAS unsigned char*)lds_raw;
__global__ void __launch_bounds__(512) k_prep(Params p) { LDSDECL phase_prep(lds, p); }
__global__ void __launch_bounds__(512) k_norm(Params p) { phase_norm(p, p.ph_lo); }
__global__ void __launch_bounds__(512) k_final(Params p) { phase_final(p); }
__global__ void __launch_bounds__(512) k_g1(Params p) { LDSDECL int l = p.ph_lo;
  pg8::Gemm g{(const pg8::bf16_t*)(p.ws + WS_HX), (const pg8::bf16_t*)(p.ws + WS_WIN) + (size_t)l * NG1 * 2048, NTOK, NG1, 2048, 2048};
  pg8::StaticOrder S; S.init(NTOK, NG1, (int)gridDim.x, lbid()); EpiIn E{(bf16_t*)(p.ws + WS_P), (float*)(p.ws + WS_GT)};
  pg8::gemm_phase<EpiIn, pg8::StaticOrder>(lds, g, S, E); }
__global__ void __launch_bounds__(512) k_g2(Params p) { LDSDECL int l = p.ph_lo; const int M = (l == DEPTH - 1) ? 8192 : NTOK;
  pg8::Gemm g{(const pg8::bf16_t*)(p.ws + WS_Y), (const pg8::bf16_t*)(p.ws + WS_WOUT) + (size_t)l * 2048 * 2048, M, 2048, 2048, 2048};
  pg8::StaticOrder S; S.init(M, 2048, (int)gridDim.x, lbid()); EpiOut E{p, l};
  pg8::gemm_phase<EpiOut, pg8::StaticOrder>(lds, g, S, E); }
__global__ void __launch_bounds__(512) k_m1(Params p) { LDSDECL for (int t = lbid(); t < 272; t += gridDim.x) m1_task(lds, p, p.ph_lo, t); }
__global__ void __launch_bounds__(512) k_m2(Params p) { phase_m2(p); }
__global__ void __launch_bounds__(512) k_m3(Params p) { LDSDECL for (int t = lbid(); t < 544; t += gridDim.x) m3_task(lds, p, p.ph_lo, t); }
__global__ void __launch_bounds__(512) k_r0(Params p) { LDSDECL for (int t = lbid(); t < 544; t += gridDim.x) r_task(lds, p, p.ph_lo, t, 0); }
__global__ void __launch_bounds__(512) k_r1(Params p) { LDSDECL for (int t = lbid(); t < 544; t += gridDim.x) r_task(lds, p, p.ph_lo, t, 1); }
#endif


#ifdef PROBE
__global__ void __launch_bounds__(512) k_dump(Params p, size_t off, int isbf, size_t nelem) {
    for (size_t i = (size_t)lbid() * 512 + ltid(); i < (size_t)8192 * 2048; i += (size_t)gridDim.x * 512) {
        const size_t j = i % nelem; p.out[i] = isbf ? bf2f(((const bf16_t*)(p.ws + off))[j]) : ((const float*)(p.ws + off))[j]; }
}
#endif

extern "C" void kernel_launch(void* const* d_in, const int* in_sizes, int n_in, void* d_out, int out_size, void* d_ws, size_t ws_size, hipStream_t stream) {
    static int grid = 0;
    if (grid == 0) {
        int dev = 0, cus = 0, per_cu = 0;
        hipGetDevice(&dev); hipDeviceGetAttribute(&cus, hipDeviceAttributeMultiprocessorCount, dev);
#if SINGLE_LAUNCH
        if (hipFuncSetAttribute((const void*)fwd_kernel, hipFuncAttributeMaxDynamicSharedMemorySize, LDS_BYTES) != hipSuccess) { fprintf(stderr, "hipFuncSetAttribute failed\n"); grid = -1; return; }
        if (hipOccupancyMaxActiveBlocksPerMultiprocessor(&per_cu, (const void*)fwd_kernel, 512, LDS_BYTES) != hipSuccess || per_cu < 1) { fprintf(stderr, "occupancy query: %d\n", per_cu); per_cu = 1; }
#else
        { const void* ks[] = {(const void*)k_prep, (const void*)k_g1, (const void*)k_g2, (const void*)k_m1, (const void*)k_m3, (const void*)k_r0, (const void*)k_r1};
          for (int i = 0; i < 7; ++i) if (hipFuncSetAttribute(ks[i], hipFuncAttributeMaxDynamicSharedMemorySize, LDS_BYTES) != hipSuccess) { fprintf(stderr, "hipFuncSetAttribute failed\n"); grid = -1; return; } }
        per_cu = 1;
#endif
        (void)hipGetLastError();
        grid = cus * 1;
        if (ws_size < WS_END) { fprintf(stderr, "workspace too small\n"); grid = -1; return; }
    }
    if (grid < 0) return;
    Params p{};
    p.x = (const float*)d_in[0]; p.c = (const float*)d_in[1]; p.ctx = (const float*)d_in[2]; p.c_ctx = (const float*)d_in[3]; p.w_mod = (const float*)d_in[4]; p.b_mod = (const float*)d_in[5];
    p.norm_g = (const float*)d_in[6]; p.w_in = (const float*)d_in[7]; p.b_gate = (const float*)d_in[8]; p.cqw = (const float*)d_in[9]; p.cqb = (const float*)d_in[10]; p.mng = (const float*)d_in[11];
    p.crw = (const float*)d_in[12]; p.crb = (const float*)d_in[13]; p.w_rg = (const float*)d_in[14]; p.b_rg = (const float*)d_in[15]; p.lam = (const float*)d_in[16]; p.w_out = (const float*)d_in[17];
    p.final_g = (const float*)d_in[18]; p.out = (float*)d_out; p.ws = (unsigned char*)d_ws;
#if SINGLE_LAUNCH
    p.ph_lo = 0; p.ph_hi = NPHASE;
    void* args[] = {&p};
    hipError_t e = hipLaunchCooperativeKernel((const void*)fwd_kernel, dim3(grid), dim3(512), args, LDS_BYTES, stream);
    if (e != hipSuccess) fprintf(stderr, "cooperative launch failed: %s (grid %d)\n", hipGetErrorString(e), grid);
#else
    p.ph_lo = 0; p.ph_hi = 0;
    hipLaunchKernelGGL(k_prep, dim3(grid), dim3(512), LDS_BYTES, stream, p);
    for (int l = 0; l < DEPTH; ++l) { p.ph_lo = l;
        hipLaunchKernelGGL(k_norm, dim3(grid), dim3(512), 0, stream, p);
#if defined(PROBE) && PROBE == 0
        hipLaunchKernelGGL(k_dump, dim3(grid), dim3(512), 0, stream, p, WS_HX, 1, (size_t)NTOK * 2048); return;
#endif
        hipLaunchKernelGGL(k_g1, dim3(grid), dim3(512), LDS_BYTES, stream, p);
#if defined(PROBE) && PROBE == 1
        hipLaunchKernelGGL(k_dump, dim3(grid), dim3(512), 0, stream, p, WS_P + (size_t)1024 * NPC * 2, 1, (size_t)8192 * 2048); return;
#endif
        hipLaunchKernelGGL(k_m1, dim3(grid), dim3(512), LDS_BYTES, stream, p);
        hipLaunchKernelGGL(k_r0, dim3(grid), dim3(512), LDS_BYTES, stream, p);
        hipLaunchKernelGGL(k_m2, dim3(grid), dim3(512), 0, stream, p);
#if defined(PROBE) && PROBE == 2
        hipLaunchKernelGGL(k_dump, dim3(grid), dim3(512), 0, stream, p, WS_CIN, 1, (size_t)272 * 32768); return;
#endif
        hipLaunchKernelGGL(k_m3, dim3(grid), dim3(512), LDS_BYTES, stream, p);
        hipLaunchKernelGGL(k_r1, dim3(grid), dim3(512), LDS_BYTES, stream, p);
#if defined(PROBE) && PROBE == 3
        hipLaunchKernelGGL(k_dump, dim3(grid), dim3(512), 0, stream, p, WS_Y, 1, (size_t)8192 * 2048); return;
#endif
        hipLaunchKernelGGL(k_g2, dim3(grid), dim3(512), LDS_BYTES, stream, p); }
    hipLaunchKernelGGL(k_final, dim3(grid), dim3(512), 0, stream, p);
#endif
}
```

```cpp
#include <hip/hip_runtime.h>
#include <hip/hip_cooperative_groups.h>
#include <cstdio>
namespace cg = cooperative_groups;
__device__ __forceinline__ int ltid() { int t = threadIdx.x; asm volatile("" : "+v"(t)); return t; }
__device__ __forceinline__ int lbid() { int b = blockIdx.x; asm volatile("" : "+s"(b)); return b; }
namespace pg8 {
#define PG8_LAS __attribute__((address_space(3)))
typedef unsigned short bf16_t;
typedef short bf16x8 __attribute__((ext_vector_type(8)));
typedef float f32x4 __attribute__((ext_vector_type(4)));
typedef unsigned u32x4 __attribute__((ext_vector_type(4)));
constexpr int BM = 256, BK = 64, HALF = 128, HTB = HALF * BK * 2  , STAGE_BYTES = 8 * HTB, NXCD = 8, WGM = 8;

__host__ __device__ __forceinline__ int lds_byte(int r, int c) { const int st = (r >> 4) * 2 + (c >> 5), rr = r & 15, cc = c & 31, ob = rr * 64 + cc * 2; return st * 1024 + (ob ^ (((ob >> 9) & 1) << 5)); }
__host__ __device__ __forceinline__ void stage_rc(int b, int& R, int& C) { const int st = b / 1024, sb = b % 1024, swz = sb ^ (((sb >> 9) & 1) << 5); R = (st >> 1) * 16 + swz / 64; C = (st & 1) * 32 + (swz % 64) / 2; }
__host__ __device__ __forceinline__ int perm32(int rho) { const int n = rho >> 4, i = rho & 15; return 8 * (i >> 2) + 4 * n + (i & 3); }

struct Unit { int pm, pn; };
struct Gemm { const bf16_t* A; const bf16_t* Bt; int M, N, K, ld; };

struct StaticOrder {
    int nM, nN, nwg, G, c;
    __host__ __device__ void init(int M, int N, int G_, int c_) { nM = M / BM; nN = N / BM; nwg = nM * nN; G = G_; c = c_; }
    __host__ __device__ bool next(int i, Unit& u) const {
        const long L = (long)i * G + c; if (L >= nwg) return false;
        int wgid = (int)L; { const int q = nwg / NXCD, r = nwg % NXCD, xcd = wgid % NXCD, off = wgid / NXCD; wgid = (xcd < r ? xcd * (q + 1) : r * (q + 1) + (xcd - r) * q) + off; }
        const int nig = WGM * nN, gid = wgid / nig, fm = gid * WGM, gsz = (nM - fm) < WGM ? (nM - fm) : WGM;
        u.pm = fm + ((wgid % nig) % gsz); u.pn = (wgid % nig) / gsz; return true;
    }
    __device__ __forceinline__ void a_ready(const Unit&) const {}
    __device__ __forceinline__ void done(const Unit&) const {}
};
__device__ __forceinline__ unsigned cvt_pk_bf16(float lo, float hi) { unsigned r; asm volatile("v_cvt_pk_bf16_f32 %0, %1, %2" : "=v"(r) : "v"(lo), "v"(hi)); return r; }
template <class Epi, class Sched>
__device__ __forceinline__ void gemm_phase(PG8_LAS unsigned char* lds, const Gemm g, const Sched& S, const Epi& E) {
    const int tid = ltid(), wid = __builtin_amdgcn_readfirstlane(tid >> 6), lane = tid & 63, wr = wid >> 2, wc = wid & 3, fr = lane & 15, fq = lane >> 4;
    const int K = g.K, nt = K / BK;
    unsigned voffA[2], voffB[2];
#pragma unroll
    for (int i = 0; i < 2; ++i) { int R, C; stage_rc(tid * 16 + i * 8192, R, C); const int Rb = Epi::PERM ? ((R & ~31) + perm32(R & 31)) : R;
        voffA[i] = (unsigned)(R * g.ld + C) * 2u; voffB[i] = (unsigned)(Rb * g.ld + C) * 2u; }
    const size_t kstep = (size_t)(BK * 2);
    const size_t hstep = (size_t)HALF * g.ld * 2;
    const size_t tstep = 2 * hstep;
    const unsigned ldsw = (unsigned)wid * 1024u;
    const int aoff = lds_byte(wr * 64 + fr, fq * 8), boff = lds_byte(wc * 32 + fr, fq * 8);
#define PG8_SA(b, h) (((b) * 2 + (h)) * HTB)
#define PG8_SB(b, h) ((4 + (b) * 2 + (h)) * HTB)
#define PG8_STAGE(bufoff, gbase, voff) do { _Pragma("unroll") for (int _i = 0; _i < 2; ++_i) \
        __builtin_amdgcn_global_load_lds((const unsigned*)((const char*)(gbase) + (voff)[_i]), (PG8_LAS unsigned*)(lds + (bufoff) + ldsw + _i * 8192), 16, 0, 0); } while (0)
#define PG8_LDA(dst, b, h) do { _Pragma("unroll") for (int m = 0; m < 4; ++m) _Pragma("unroll") for (int k = 0; k < 2; ++k) dst[m][k] = *(const PG8_LAS bf16x8*)(lds + PG8_SA(b, h) + aoff + m * 2048 + k * 1024); } while (0)
#define PG8_LDB(dst, b, h) do { _Pragma("unroll") for (int n = 0; n < 2; ++n) _Pragma("unroll") for (int k = 0; k < 2; ++k) dst[n][k] = *(const PG8_LAS bf16x8*)(lds + PG8_SB(b, h) + boff + n * 2048 + k * 1024); } while (0)
#define PG8_MMA(ai, bj, At, Bt) do { __builtin_amdgcn_s_setprio(1); _Pragma("unroll") for (int m = 0; m < 4; ++m) _Pragma("unroll") for (int n = 0; n < 2; ++n) _Pragma("unroll") for (int k = 0; k < 2; ++k) \
        acc[ai][bj][m][n] = __builtin_amdgcn_mfma_f32_16x16x32_bf16(Bt[n][k], At[m][k], acc[ai][bj][m][n], 0, 0, 0); __builtin_amdgcn_s_setprio(0); } while (0)
#define PG8_WAIT_V(n) asm volatile("s_waitcnt vmcnt(" #n ")" ::: "memory")
#define PG8_WAIT_L(n) asm volatile("s_waitcnt lgkmcnt(" #n ")" ::: "memory")
#define PG8_BAR __builtin_amdgcn_s_barrier()
#define PG8_SCHED __builtin_amdgcn_sched_barrier(0)
    Unit cur, nxt; int ui = 0;
    if (!S.next(0, cur)) return;
    f32x4 acc[2][2][4][2];
#pragma unroll
    for (int a = 0; a < 2; ++a)
#pragma unroll
        for (int b = 0; b < 2; ++b)
#pragma unroll
            for (int m = 0; m < 4; ++m)
#pragma unroll
                for (int n = 0; n < 2; ++n) acc[a][b][m][n] = (f32x4){0.f, 0.f, 0.f, 0.f};
    bf16x8 At[4][2], B0[2][2], B1[2][2];
    const char* cA = (const char*)g.A + (size_t)cur.pm * tstep; const char* cB = (const char*)g.Bt + (size_t)cur.pn * tstep;
    S.a_ready(cur);
    PG8_STAGE(PG8_SB(0, 0), cB, voffB); PG8_STAGE(PG8_SA(0, 0), cA, voffA); PG8_STAGE(PG8_SB(0, 1), cB + hstep, voffB); PG8_STAGE(PG8_SA(0, 1), cA + hstep, voffA);
    if (wr == 1) PG8_BAR;
    PG8_WAIT_V(4); PG8_BAR;
    PG8_STAGE(PG8_SB(1, 0), cB + kstep, voffB); PG8_STAGE(PG8_SA(1, 0), cA + kstep, voffA); PG8_STAGE(PG8_SB(1, 1), cB + hstep + kstep, voffB);
    PG8_WAIT_V(6); PG8_BAR;
    for (;;) {
        const bool has_next = S.next(ui + 1, nxt);
        const char* nA = has_next ? (const char*)g.A + (size_t)nxt.pm * tstep : cA; const char* nB = has_next ? (const char*)g.Bt + (size_t)nxt.pn * tstep : cB;
        for (int t = 0; t < nt; t += 2) {
            const bool last = (t == nt - 2);
            const char* a1 = cA + (size_t)(t + 1) * kstep;
            const char* a2 = last ? nA : cA + (size_t)(t + 2) * kstep; const char* b2 = last ? nB : cB + (size_t)(t + 2) * kstep;
            const char* a3 = a2 + kstep; const char* b3 = b2 + kstep;
            if (last && has_next) S.a_ready(nxt);
            PG8_LDB(B0, 0, 0); PG8_SCHED; PG8_LDA(At, 0, 0); PG8_STAGE(PG8_SA(1, 1), a1 + hstep, voffA);
            PG8_WAIT_L(8); PG8_BAR; PG8_WAIT_L(0); PG8_MMA(0, 0, At, B0); PG8_BAR; PG8_SCHED;
            PG8_LDB(B1, 0, 1); PG8_STAGE(PG8_SB(0, 0), b2, voffB);
            PG8_BAR; PG8_WAIT_L(0); PG8_MMA(0, 1, At, B1); PG8_BAR;
            PG8_LDA(At, 0, 1); PG8_STAGE(PG8_SA(0, 0), a2, voffA);
            PG8_BAR; PG8_WAIT_L(0); PG8_MMA(1, 0, At, B0); PG8_BAR; PG8_SCHED;
            PG8_STAGE(PG8_SB(0, 1), b2 + hstep, voffB);
            PG8_WAIT_V(6); PG8_BAR; PG8_MMA(1, 1, At, B1); PG8_BAR;
            PG8_LDB(B0, 1, 0); PG8_SCHED; PG8_LDA(At, 1, 0); PG8_STAGE(PG8_SA(0, 1), a2 + hstep, voffA);
            PG8_WAIT_L(8); PG8_BAR; PG8_WAIT_L(0); PG8_MMA(0, 0, At, B0); PG8_BAR; PG8_SCHED;
            PG8_LDB(B1, 1, 1); PG8_STAGE(PG8_SB(1, 0), b3, voffB);
            PG8_BAR; PG8_WAIT_L(0); PG8_MMA(0, 1, At, B1); PG8_BAR;
            PG8_LDA(At, 1, 1); PG8_STAGE(PG8_SA(1, 0), a3, voffA);
            PG8_BAR; PG8_WAIT_L(0); PG8_MMA(1, 0, At, B0); PG8_BAR; PG8_SCHED;
            PG8_STAGE(PG8_SB(1, 1), b3 + hstep, voffB);
            PG8_WAIT_V(6); PG8_BAR; PG8_MMA(1, 1, At, B1); PG8_BAR;
        }
        if constexpr (!Epi::AFTER_DRAIN) { E(acc, cur, wr, wc, fr, fq); S.done(cur); }
        if (!has_next) break;
#pragma unroll
        for (int a = 0; a < 2; ++a)
#pragma unroll
            for (int b = 0; b < 2; ++b)
#pragma unroll
                for (int m = 0; m < 4; ++m)
#pragma unroll
                    for (int n = 0; n < 2; ++n) acc[a][b][m][n] = (f32x4){0.f, 0.f, 0.f, 0.f};
        cur = nxt; cA = nA; cB = nB; ++ui;
    }
    PG8_WAIT_V(0);
    if (wr == 0) PG8_BAR;
    PG8_BAR;
    if constexpr (Epi::AFTER_DRAIN) { E.fused(acc, cur, wr, wc, fr, fq, lds, wid, lane); S.done(cur); }
#undef PG8_SA
#undef PG8_SB
#undef PG8_STAGE
#undef PG8_LDA
#undef PG8_LDB
#undef PG8_MMA
#undef PG8_WAIT_V
#undef PG8_WAIT_L
#undef PG8_BAR
#undef PG8_SCHED
}
}

__device__ __forceinline__ float shx(float v, int m) {
    const int x = __float_as_int(v); int y;
    switch (m) {
        case 1: y = __builtin_amdgcn_ds_swizzle(x, (1 << 10) | 0x1f); break;
        case 2: y = __builtin_amdgcn_ds_swizzle(x, (2 << 10) | 0x1f); break;
        case 4: y = __builtin_amdgcn_ds_swizzle(x, (4 << 10) | 0x1f); break;
        case 8: y = __builtin_amdgcn_ds_swizzle(x, (8 << 10) | 0x1f); break;
        case 16: y = __builtin_amdgcn_ds_swizzle(x, (16 << 10) | 0x1f); break;
        default: return __shfl_xor(v, 32);
    }
    return __int_as_float(y);
}

#define DI __device__ __forceinline__
#define LAS __attribute__((address_space(3)))
typedef unsigned short bf16_t;
typedef short bf16x8 __attribute__((ext_vector_type(8)));
typedef float f32x4 __attribute__((ext_vector_type(4)));
typedef unsigned u32x4 __attribute__((ext_vector_type(4)));
typedef unsigned u32x2 __attribute__((ext_vector_type(2)));

#ifndef REP_M1
#define REP_M1 1
#endif
#ifndef REP_M3
#define REP_M3 1
#endif
#ifndef REP_R0
#define REP_R0 1
#endif
#ifndef REP_R1
#define REP_R1 1
#endif
#ifndef REP_M2
#define REP_M2 1
#endif
#ifndef REP_PREP
#define REP_PREP 1
#endif
#ifndef REP_G1
#define REP_G1 1
#endif
#ifndef REP_N
#define REP_N 1
#endif
#ifndef SINGLE_LAUNCH
#define SINGLE_LAUNCH 1
#endif
constexpr int NTOK = 8704, NPC = 6144, NG1 = 6400, DEPTH = 4, NPHASE = 26;
constexpr int LDS_BYTES = 147456;
constexpr size_t al256(size_t x) { return (x + 255) & ~(size_t)255; }
constexpr size_t WS_WIN = 0;
constexpr size_t WS_WOUT = WS_WIN + al256((size_t)4 * NG1 * 2048 * 2);
constexpr size_t WS_WRT = WS_WOUT + al256((size_t)4 * 2048 * 2048 * 2);
constexpr size_t WS_MOD = WS_WRT + al256((size_t)256 * 4096 * 2);
constexpr size_t MOD_BYTES = (size_t)4 * 3 * 6144 * 4;
constexpr size_t WS_HX = WS_MOD + al256(MOD_BYTES);
constexpr size_t WS_P = WS_HX + al256((size_t)NTOK * 2048 * 2);
constexpr size_t WS_GT = WS_P + al256((size_t)NTOK * NPC * 2);
constexpr size_t WS_XB = WS_GT + al256((size_t)NTOK * 16 * 4);
constexpr size_t WS_Y = WS_XB + al256((size_t)NTOK * 2048 * 4);
constexpr size_t WS_QC = WS_Y + al256((size_t)NTOK * 2048 * 2);
constexpr size_t WS_KC = WS_QC + al256((size_t)8 * 4352 * 128 * 2);
constexpr size_t WS_VT = WS_KC + al256((size_t)8 * 4352 * 128 * 2);
constexpr size_t WS_EG = WS_VT + al256((size_t)8 * 17 * 4 * 256 * 64 * 2);
constexpr size_t WS_BG = WS_EG + al256((size_t)16 * 4352 * 4);
constexpr size_t WS_JS = WS_BG + al256((size_t)16 * 4352 * 4);
constexpr size_t WS_DC = WS_JS + al256((size_t)272 * 2 * 4);
constexpr size_t WS_DN = WS_DC + al256((size_t)272 * 32768 * 4);
constexpr size_t WS_CIN = WS_DN + al256((size_t)272 * 128 * 4);
constexpr size_t WS_NIN = WS_CIN + al256((size_t)272 * 32768 * 2);
constexpr size_t WS_MIN = WS_NIN + al256((size_t)272 * 128 * 4);
constexpr size_t WS_RAGG = WS_MIN + al256((size_t)272 * 4);
constexpr size_t WS_LU = WS_RAGG + al256((size_t)34 * 2 * 1024 * 2 * 4);
constexpr size_t WS_PART = WS_LU + al256((size_t)2 * NTOK * 1024 * 4);
constexpr size_t WS_END = WS_PART + al256((size_t)8 * 512 * 2048 * 4);

struct Params {
    const float *x, *c, *ctx, *c_ctx, *w_mod, *b_mod, *norm_g, *w_in, *b_gate, *cqw, *cqb, *mng, *crw, *crb, *w_rg, *b_rg, *lam, *w_out, *final_g;
    float* out; unsigned char* ws; int ph_lo, ph_hi;
};

DI unsigned pk2(float lo, float hi) { unsigned r; asm("v_cvt_pk_bf16_f32 %0, %1, %2" : "=v"(r) : "v"(lo), "v"(hi)); return r; }
DI unsigned f2bf(float f) { return pk2(f, f) & 0xffffu; }
DI float bf2f(unsigned h) { return __uint_as_float(h << 16); }
DI float bflo(unsigned w) { return __uint_as_float(w << 16); }
DI float bfhi(unsigned w) { return __uint_as_float(w & 0xffff0000u); }
DI float sigm(float x) { return __builtin_amdgcn_rcpf(1.f + __expf(-x)); }
DI float one_m_expneg(float t, float a2) { const float pl = t * (1.f - t * 0.5f * (1.f - t * (1.f / 3.f) * (1.f - t * 0.25f * (1.f - t * 0.2f * (1.f - t * (1.f / 6.f) * (1.f - t * (1.f / 7.f))))))); return t < 0.25f ? pl : 1.f - a2; }
#define MFMA16(a, b, c) __builtin_amdgcn_mfma_f32_16x16x32_bf16((a), (b), (c), 0, 0, 0)
DI const float* xsrc(const Params& p, int l, int row) {
    if (l == 0) return row < 8192 ? p.x + (size_t)row * 2048 : p.ctx + (size_t)(row - 8192) * 2048;
    return (const float*)(p.ws + WS_XB) + (size_t)row * 2048;
}
DI int pos_row(int b, int pp) { if (pp < 256) return 8192 + b * 256 + pp; const int q = pp - 256; return b * 4096 + (q & 63) * 64 + (q >> 6); }

DI void tr_tile(LAS unsigned char* lds, const float* src, int ld_src, int k0, int n0, int ncols, bf16_t* dst, int ld_dst, int mode) {
    LAS bf16_t* T = (LAS bf16_t*)lds;
    const int tid = ltid(), kr = tid >> 4, nc = tid & 15;
    { const int n = n0 + 4 * nc; float4 v0 = make_float4(0.f, 0.f, 0.f, 0.f), v1 = v0;
      if (n < ncols) { v0 = *(const float4*)(src + (size_t)(k0 + 2 * kr) * ld_src + n); v1 = *(const float4*)(src + (size_t)(k0 + 2 * kr + 1) * ld_src + n); }
      LAS unsigned* T32 = (LAS unsigned*)lds;
      T32[(4 * nc + 0) * 36 + kr] = pk2(v0.x, v1.x); T32[(4 * nc + 1) * 36 + kr] = pk2(v0.y, v1.y);
      T32[(4 * nc + 2) * 36 + kr] = pk2(v0.z, v1.z); T32[(4 * nc + 3) * 36 + kr] = pk2(v0.w, v1.w); }
    __syncthreads();
    { const int n = tid >> 3, kc = tid & 7, sn = n0 + n;
      if (sn < ncols) { const int dr = mode == 1 ? (sn < 4096 ? sn : (sn < 4112 ? 6144 + sn - 4096 : sn - 16)) : sn;
          const u32x4 w = *(LAS u32x4*)(T + n * 72 + 8 * kc); *(u32x4*)(dst + (size_t)dr * ld_dst + k0 + 8 * kc) = w; } }
    __syncthreads();
}
DI void tr_tile4(LAS unsigned char* lds, const float* src, int ld_src, int k0, int n0, int ncols, bf16_t* dst, int ld_dst, int mode) {
    LAS unsigned* T32 = (LAS unsigned*)lds;
    const int tid = ltid(), kr = tid >> 4, nc = tid & 15;
    float4 v0[4], v1[4];
#pragma unroll
    for (int ti = 0; ti < 4; ++ti) { const int n = n0 + 64 * ti + 4 * nc; v0[ti] = make_float4(0.f, 0.f, 0.f, 0.f); v1[ti] = v0[ti];
        if (n < ncols) { v0[ti] = *(const float4*)(src + (size_t)(k0 + 2 * kr) * ld_src + n); v1[ti] = *(const float4*)(src + (size_t)(k0 + 2 * kr + 1) * ld_src + n); } }
#pragma unroll
    for (int ti = 0; ti < 4; ++ti) { LAS unsigned* T = T32 + ti * 2304;
        T[(4 * nc + 0) * 36 + kr] = pk2(v0[ti].x, v1[ti].x); T[(4 * nc + 1) * 36 + kr] = pk2(v0[ti].y, v1[ti].y);
        T[(4 * nc + 2) * 36 + kr] = pk2(v0[ti].z, v1[ti].z); T[(4 * nc + 3) * 36 + kr] = pk2(v0[ti].w, v1[ti].w); }
    __syncthreads();
    { const int n = tid >> 3, kc = tid & 7;
#pragma unroll
      for (int ti = 0; ti < 4; ++ti) { const int sn = n0 + 64 * ti + n;
          if (sn < ncols) { const int dr = mode == 1 ? (sn < 4096 ? sn : (sn < 4112 ? 6144 + sn - 4096 : sn - 16)) : sn;
              const u32x4 w = *(LAS u32x4*)((LAS bf16_t*)(T32 + ti * 2304) + n * 72 + 8 * kc); *(u32x4*)(dst + (size_t)dr * ld_dst + k0 + 8 * kc) = w; } } }
    __syncthreads();
}
DI void mod_task(LAS unsigned char* lds, const Params& p, int l, int cgp) {
    LAS float* red = (LAS float*)lds;
    const int tid = ltid(), kg = tid >> 4, cl = tid & 15, col = cgp * 64 + 4 * cl;
    const float* w = p.w_mod + ((size_t)l * 2048 + kg * 64) * 6144 + col;
    float4 a0 = make_float4(0.f, 0.f, 0.f, 0.f), a1 = a0, a2 = a0;
#pragma unroll 4
    for (int k = 0; k < 64; ++k) { const float4 v = *(const float4*)(w + (size_t)k * 6144); const int kk = kg * 64 + k;
        const float c0 = p.c[kk], c1 = p.c[2048 + kk], c2 = p.c_ctx[kk]; const float s0 = c0 * sigm(c0), s1 = c1 * sigm(c1), s2 = c2 * sigm(c2);
        a0.x += s0 * v.x; a0.y += s0 * v.y; a0.z += s0 * v.z; a0.w += s0 * v.w; a1.x += s1 * v.x; a1.y += s1 * v.y; a1.z += s1 * v.z; a1.w += s1 * v.w;
        a2.x += s2 * v.x; a2.y += s2 * v.y; a2.z += s2 * v.z; a2.w += s2 * v.w; }
    *(LAS f32x4*)(red + (kg * 3 + 0) * 64 + 4 * cl) = (f32x4){a0.x, a0.y, a0.z, a0.w}; *(LAS f32x4*)(red + (kg * 3 + 1) * 64 + 4 * cl) = (f32x4){a1.x, a1.y, a1.z, a1.w}; *(LAS f32x4*)(red + (kg * 3 + 2) * 64 + 4 * cl) = (f32x4){a2.x, a2.y, a2.z, a2.w};
    __syncthreads();
    if (tid < 192) { const int r = tid >> 6, c = tid & 63; float sum = 0.f;
#pragma unroll
        for (int g2 = 0; g2 < 32; ++g2) sum += red[(g2 * 3 + r) * 64 + c];
        const int col = cgp * 64 + c; const float v = sum + p.b_mod[(size_t)l * 6144 + col];
        ((float*)(p.ws + WS_MOD))[(size_t)l * 3 * 6144 + r * 6144 + col] = (col >= 2048 && col < 4096) ? (1.f + v) * p.norm_g[l * 2048 + col - 2048] : v; }
    __syncthreads();
}
DI void wconv_task(LAS unsigned char* lds, const Params& p, int l, int u) {
    if (u < 32 * 25) { const int kt = u / 25, ng = u % 25;
        tr_tile4(lds, p.w_in + (size_t)l * 2048 * 6160, 6160, kt * 64, ng * 256, 6160, (bf16_t*)(p.ws + WS_WIN) + (size_t)l * NG1 * 2048, 2048, 1); }
    else { const int r = u - 32 * 25, kt = r >> 3, ng = r & 7;
        tr_tile4(lds, p.w_out + (size_t)l * 2048 * 2048, 2048, kt * 64, ng * 256, 2048, (bf16_t*)(p.ws + WS_WOUT) + (size_t)l * 2048 * 2048, 2048, 0); }
}
constexpr int T_WCONV = 32 * 25 + 256;
DI void phase_prep(LAS unsigned char* lds, const Params& p) {
    constexpr int T_RG = 256, T_MOD = 4 * 96;
    for (int t = lbid(); t < T_MOD + T_WCONV + T_RG; t += gridDim.x) {
        if (t < T_MOD) { mod_task(lds, p, t / 96, t % 96); }
        else if (t < T_MOD + T_WCONV) wconv_task(lds, p, 0, t - T_MOD);
        else { const int m = t - T_MOD - T_WCONV; tr_tile(lds, p.w_rg + (size_t)m * 4096, 64, 0, 0, 64, (bf16_t*)(p.ws + WS_WRT) + (size_t)m * 4096, 64, 0); }
    }
}

DI float wave_sum(float v) { v += shx(v, 32); v += shx(v, 16); v += shx(v, 8); v += shx(v, 4); v += shx(v, 2); v += shx(v, 1); return v; }
DI void phase_norm(const Params& p, int l) {
    const int wid = ltid() >> 6, lane = ltid() & 63;
    const float* MOD = (const float*)(p.ws + WS_MOD) + (size_t)l * 3 * 6144; const float* bm = p.b_mod + (size_t)l * 6144; const float* g = p.norm_g + l * 2048;
    bf16_t* HX = (bf16_t*)(p.ws + WS_HX);
    const int G8 = (int)gridDim.x * 8, nlat = (8192 + G8 - 1) / G8, bid = lbid();
    for (int it = 0; ; ++it) { int row;
        if (it < nlat) { row = bid * 8 + wid + it * G8; if (row >= 8192) continue; }
        else { const int c = bid * 2 + wid + (it - nlat) * (int)gridDim.x * 2; if (wid >= 2 || c >= 512) break; row = 8192 + c; }
        const int rt = row < 8192 ? (row >> 12) : 2;
        float4 v[8]; float ss = 0.f;
        if (l > 0 && row >= 8192) {
            const float* xo = xsrc(p, l - 1, row); const float* PART = (const float*)(p.ws + WS_PART) + (size_t)(row - 8192) * 2048;
            const float* MODp = (const float*)(p.ws + WS_MOD) + (size_t)(l - 1) * 3 * 6144 + 2 * 6144 + 4096; const float* bmp = p.b_mod + (size_t)(l - 1) * 6144 + 4096;
            float* XBw = (float*)(p.ws + WS_XB) + (size_t)row * 2048;
#pragma unroll
            for (int i = 0; i < 8; ++i) { const int c = (i * 64 + lane) * 4; float4 a = *(const float4*)(PART + c);
#pragma unroll
                for (int k = 1; k < 8; ++k) { const float4 t2 = *(const float4*)(PART + (size_t)k * 512 * 2048 + c); a.x += t2.x; a.y += t2.y; a.z += t2.z; a.w += t2.w; }
                const float4 x0 = *(const float4*)(xo + c), g1 = *(const float4*)(MODp + c);
                v[i].x = x0.x + g1.x * a.x; v[i].y = x0.y + g1.y * a.y; v[i].z = x0.z + g1.z * a.z; v[i].w = x0.w + g1.w * a.w;
                *(float4*)(XBw + c) = v[i]; }
        } else { const float* xs = xsrc(p, l, row);
#pragma unroll
            for (int i = 0; i < 8; ++i) v[i] = *(const float4*)(xs + (i * 64 + lane) * 4); }
#pragma unroll
        for (int i = 0; i < 8; ++i) ss += v[i].x * v[i].x + v[i].y * v[i].y + v[i].z * v[i].z + v[i].w * v[i].w;
        ss = wave_sum(ss);
        const float rstd = rsqrtf(ss * (1.f / 2048.f) + 1e-6f);
#pragma unroll
        for (int i = 0; i < 8; ++i) { const int c = (i * 64 + lane) * 4;
            const float4 sh = *(const float4*)(MOD + rt * 6144 + c), sc = *(const float4*)(MOD + rt * 6144 + 2048 + c);
            const float y0 = v[i].x * rstd * sc.x + sh.x, y1 = v[i].y * rstd * sc.y + sh.y;
            const float y2 = v[i].z * rstd * sc.z + sh.z, y3 = v[i].w * rstd * sc.w + sh.w;
            u32x2 w; w.x = pk2(y0, y1); w.y = pk2(y2, y3); *(u32x2*)(HX + (size_t)row * 2048 + c) = w; }
    }
}
DI void phase_final(const Params& p) {
    const int wid = ltid() >> 6, lane = ltid() & 63;
    const float* XB = (const float*)(p.ws + WS_XB);
    for (int row = lbid() * 8 + wid; row < 8192; row += gridDim.x * 8) {
        const float* xs = XB + (size_t)row * 2048; float4 v[8]; float ss = 0.f;
#pragma unroll
        for (int i = 0; i < 8; ++i) { v[i] = *(const float4*)(xs + (i * 64 + lane) * 4); ss += v[i].x * v[i].x + v[i].y * v[i].y + v[i].z * v[i].z + v[i].w * v[i].w; }
        ss = wave_sum(ss);
        const float rstd = rsqrtf(ss * (1.f / 2048.f) + 1e-6f);
#pragma unroll
        for (int i = 0; i < 8; ++i) { const int c = (i * 64 + lane) * 4; const float4 gg = *(const float4*)(p.final_g + c);
            float4 o; o.x = v[i].x * rstd * gg.x; o.y = v[i].y * rstd * gg.y; o.z = v[i].z * rstd * gg.z; o.w = v[i].w * rstd * gg.w; *(float4*)(p.out + (size_t)row * 2048 + c) = o; }
    }
}

struct EpiIn {
    static constexpr bool PERM = true, AFTER_DRAIN = false;
    bf16_t* P; float* GT;
    DI void operator()(const f32x4 (&acc)[2][2][4][2], const pg8::Unit& u, int wr, int wc, int fr, int fq) const {
        const int row0 = u.pm * 256 + wr * 64 + fr;
        if (u.pn < 24) { const int col0 = u.pn * 256 + wc * 32 + 8 * fq;
#pragma unroll
            for (int ai = 0; ai < 2; ++ai)
#pragma unroll
                for (int m = 0; m < 4; ++m) { bf16_t* rowp = P + (size_t)(row0 + ai * 128 + m * 16) * NPC + col0;
#pragma unroll
                    for (int bj = 0; bj < 2; ++bj) { const f32x4 v0 = acc[ai][bj][m][0], v1 = acc[ai][bj][m][1];
                        u32x4 w; w.x = pg8::cvt_pk_bf16(v0[0], v0[1]); w.y = pg8::cvt_pk_bf16(v0[2], v0[3]); w.z = pg8::cvt_pk_bf16(v1[0], v1[1]); w.w = pg8::cvt_pk_bf16(v1[2], v1[3]);
                        *(u32x4*)(rowp + bj * 128) = w; } }
        } else if (wc == 0 && fq < 2) {
#pragma unroll
            for (int ai = 0; ai < 2; ++ai)
#pragma unroll
                for (int m = 0; m < 4; ++m) { float* rp = GT + (size_t)(row0 + ai * 128 + m * 16) * 16 + 8 * fq; *(f32x4*)rp = acc[ai][0][m][0]; *(f32x4*)(rp + 4) = acc[ai][0][m][1]; }
        }
    }
};
struct EpiOut {
    static constexpr bool PERM = false, AFTER_DRAIN = false;
    Params p; int l;
    DI void operator()(const f32x4 (&acc)[2][2][4][2], const pg8::Unit& u, int wr, int wc, int fr, int fq) const {
        const int row0 = u.pm * 256 + wr * 64 + fr, col0 = u.pn * 256 + wc * 32 + 4 * fq, rt = u.pm < 32 ? (u.pm >> 4) : 2;
        const float* MOD = (const float*)(p.ws + WS_MOD) + (size_t)l * 3 * 6144 + rt * 6144 + 4096; const float* bm = p.b_mod + (size_t)l * 6144 + 4096;
        f32x4 gt[2][2];
#pragma unroll
        for (int bj = 0; bj < 2; ++bj)
#pragma unroll
            for (int n = 0; n < 2; ++n) gt[bj][n] = *(const f32x4*)(MOD + col0 + bj * 128 + n * 16);
        float* XB = (float*)(p.ws + WS_XB);
#pragma unroll
        for (int ai = 0; ai < 2; ++ai)
#pragma unroll
            for (int m = 0; m < 4; ++m) { const int r = row0 + ai * 128 + m * 16; const float* xs = xsrc(p, l, r) + col0; float* xo = XB + (size_t)r * 2048 + col0;
#pragma unroll
                for (int bj = 0; bj < 2; ++bj)
#pragma unroll
                    for (int n = 0; n < 2; ++n) { const f32x4 o = *(const f32x4*)(xs + bj * 128 + n * 16) + gt[bj][n] * acc[ai][bj][m][n]; *(f32x4*)(xo + bj * 128 + n * 16) = o; } }
    }
};

struct OneUnit { int pm, pn;
    DI bool next(int i, pg8::Unit& u) const { if (i) return false; u.pm = pm; u.pn = pn; return true; }
    DI void a_ready(const pg8::Unit&) const {}
    DI void done(const pg8::Unit&) const {} };
struct EpiPart {
    static constexpr bool PERM = false, AFTER_DRAIN = false;
    float* part;
    DI void operator()(const f32x4 (&acc)[2][2][4][2], const pg8::Unit& u, int wr, int wc, int fr, int fq) const {
        const int row0 = (u.pm - 32) * 256 + wr * 64 + fr, col0 = u.pn * 256 + wc * 32 + 4 * fq;
#pragma unroll
        for (int ai = 0; ai < 2; ++ai)
#pragma unroll
            for (int m = 0; m < 4; ++m) { float* xo = part + (size_t)(row0 + ai * 128 + m * 16) * 2048 + col0;
#pragma unroll
                for (int bj = 0; bj < 2; ++bj)
#pragma unroll
                    for (int n = 0; n < 2; ++n) *(f32x4*)(xo + bj * 128 + n * 16) = acc[ai][bj][m][n]; }
    }
};

DI void m1_task(LAS unsigned char* lds, const Params& p, int l, int task) {
    const int dir = task & 1, J = (task >> 1) % 17, bh = (task >> 1) / 17, b = bh >> 2, h = bh & 3;
    const int chain = bh * 2 + dir, sidx = chain * 17 + J;
    const int tid = ltid(), wid = tid >> 6, lane = tid & 63, r = lane & 15, q = lane >> 4;
    LAS bf16_t* Ktw = (LAS bf16_t*)lds;
    LAS bf16_t* Vts = (LAS bf16_t*)(lds + 18432);
    LAS float* wv = (LAS float*)(lds + 55296);
    LAS float* sc = (LAS float*)(lds + 56320);
    const bf16_t* P = (const bf16_t*)(p.ws + WS_P); const float* GT = (const float*)(p.ws + WS_GT);
    float* EG = (float*)(p.ws + WS_EG); float* BG = (float*)(p.ws + WS_BG); float* JS = (float*)(p.ws + WS_JS);
    float e_val = 0.f, bsum = 0.f; const int idx = dir ? 255 - tid : tid;
    if (tid < 256) {
        const int row = pos_row(b, J * 256 + idx);
        const float ig = GT[(size_t)row * 16 + dir * 8 + h] + p.b_gate[l * 16 + dir * 8 + h];
        const float fg = GT[(size_t)row * 16 + dir * 8 + 4 + h] + p.b_gate[l * 16 + dir * 8 + 4 + h];
        float s = fminf(fg, 0.f) - __logf(1.f + __expf(-fabsf(fg)));
#pragma unroll
        for (int o = 1; o < 64; o <<= 1) { const float t = __shfl_up(s, o); if (lane >= o) s += t; }
        if (lane == 63) sc[wid] = s;
        bsum = s; e_val = ig;
    }
    __syncthreads();
    if (tid < 256) { float off = 0.f; for (int w = 0; w < wid; ++w) off += sc[w]; bsum += off; e_val -= bsum;
        EG[(size_t)chain * 4352 + J * 256 + idx] = e_val; BG[(size_t)chain * 4352 + J * 256 + idx] = bsum;
        float m = e_val;
#pragma unroll
        for (int o = 32; o; o >>= 1) m = fmaxf(m, shx(m, o));
        if (lane == 0) sc[8 + wid] = m; }
    __syncthreads();
    const float emax = fmaxf(fmaxf(sc[8], sc[9]), fmaxf(sc[10], sc[11])), Btot = sc[0] + sc[1] + sc[2] + sc[3];
    if (tid < 256) wv[idx] = __expf(e_val - emax);
    if (tid == 0) { JS[sidx * 2] = Btot; JS[sidx * 2 + 1] = Btot + emax; }
    __syncthreads();
    f32x4 acc[2][8];
#pragma unroll
    for (int a = 0; a < 2; ++a)
#pragma unroll
        for (int n = 0; n < 8; ++n) acc[a][n] = (f32x4){0.f, 0.f, 0.f, 0.f};
    float dn_acc = 0.f;
    const int seq_lo = (J == 0) ? 0 : 256, seq_hi = (J == 0) ? 256 : 4352;
    bf16_t* QC = (bf16_t*)(p.ws + WS_QC); bf16_t* KC = (bf16_t*)(p.ws + WS_KC); bf16_t* VT = (bf16_t*)(p.ws + WS_VT);
#pragma unroll 1
    for (int sb = 0; sb < 4; ++sb) {
        u32x4 rv[4];
        { const bf16_t* vsrc = P + (size_t)pos_row(b, J * 256 + sb * 64 + (tid & 63)) * NPC + 1024 + h * 256 + (tid >> 6) * 32;
#pragma unroll
          for (int i = 0; i < 4; ++i) rv[i] = *(const u32x4*)(vsrc + 8 * i); }
        { const int s = tid & 63, dg = __builtin_amdgcn_readfirstlane(tid >> 6), pl = sb * 64 + s, pp = J * 256 + pl;
#pragma unroll 1
          for (int which = (dir == 0 ? 0 : 1); which < 2; ++which) {
              const int cbase = which * 512 + h * 128 + dg * 16;
              float a[16];
#pragma unroll
              for (int i = 0; i < 16; i += 4) { const float4 bb = *(const float4*)(p.cqb + l * 1024 + cbase + i); a[i] = bb.x; a[i + 1] = bb.y; a[i + 2] = bb.z; a[i + 3] = bb.w; }
#pragma unroll
              for (int j = 0; j < 4; ++j) { const int pq = pp - 1 + j;
                  if (pq >= seq_lo && pq < seq_hi) { const bf16_t* src = P + (size_t)pos_row(b, pq) * NPC + cbase; const float* wp = p.cqw + (size_t)(l * 4 + j) * 1024 + cbase;
#pragma unroll
                      for (int i8 = 0; i8 < 2; ++i8) { const u32x4 w = *(const u32x4*)(src + 8 * i8); const float4 w0 = *(const float4*)(wp + 8 * i8), w1 = *(const float4*)(wp + 8 * i8 + 4);
                          a[8 * i8 + 0] += w0.x * bflo(w.x); a[8 * i8 + 1] += w0.y * bfhi(w.x); a[8 * i8 + 2] += w0.z * bflo(w.y); a[8 * i8 + 3] += w0.w * bfhi(w.y);
                          a[8 * i8 + 4] += w1.x * bflo(w.z); a[8 * i8 + 5] += w1.y * bfhi(w.z); a[8 * i8 + 6] += w1.z * bflo(w.w); a[8 * i8 + 7] += w1.w * bfhi(w.w); } } }
              const float scale = which ? 0.08838834764831845f : 1.f;
#pragma unroll
              for (int i = 0; i < 16; ++i) a[i] = a[i] * sigm(a[i]) * scale;
              u32x4 o0, o1; o0.x = pk2(a[0], a[1]); o0.y = pk2(a[2], a[3]); o0.z = pk2(a[4], a[5]); o0.w = pk2(a[6], a[7]);
              o1.x = pk2(a[8], a[9]); o1.y = pk2(a[10], a[11]); o1.z = pk2(a[12], a[13]); o1.w = pk2(a[14], a[15]);
              if (which == 0) { bf16_t* dst = QC + ((size_t)bh * 4352 + pp) * 128 + dg * 16; *(u32x4*)dst = o0; *(u32x4*)(dst + 8) = o1; }
              else { if (dir == 0) { bf16_t* dst = KC + ((size_t)bh * 4352 + pp) * 128 + dg * 16; *(u32x4*)dst = o0; *(u32x4*)(dst + 8) = o1; }
                  const float ws_ = wv[pl];
#pragma unroll
                  for (int i = 0; i < 16; ++i) Ktw[(dg * 16 + i) * 72 + s] = (bf16_t)f2bf(bf2f(f2bf(a[i])) * ws_); }
          } }
        { const int s = tid & 63, vg = tid >> 6;
#pragma unroll
          for (int i = 0; i < 4; ++i) { const u32x4 w = rv[i];
              Vts[(vg * 32 + 8 * i + 0) * 72 + s] = (bf16_t)(w.x & 0xffff); Vts[(vg * 32 + 8 * i + 1) * 72 + s] = (bf16_t)(w.x >> 16);
              Vts[(vg * 32 + 8 * i + 2) * 72 + s] = (bf16_t)(w.y & 0xffff); Vts[(vg * 32 + 8 * i + 3) * 72 + s] = (bf16_t)(w.y >> 16);
              Vts[(vg * 32 + 8 * i + 4) * 72 + s] = (bf16_t)(w.z & 0xffff); Vts[(vg * 32 + 8 * i + 5) * 72 + s] = (bf16_t)(w.z >> 16);
              Vts[(vg * 32 + 8 * i + 6) * 72 + s] = (bf16_t)(w.w & 0xffff); Vts[(vg * 32 + 8 * i + 7) * 72 + s] = (bf16_t)(w.w >> 16); } }
        __syncthreads();
        if (dir == 0) { const int v = tid >> 1, half = tid & 1; bf16_t* dst = VT + ((((size_t)bh * 17 + J) * 4 + sb) * 256 + v) * 64 + half * 32;
#pragma unroll
            for (int i = 0; i < 4; ++i) *(u32x4*)(dst + 8 * i) = *(LAS u32x4*)(Vts + v * 72 + half * 32 + 8 * i); }
        if (tid < 128) { float sum = 0.f;
#pragma unroll
            for (int i = 0; i < 8; ++i) { const u32x4 w = *(LAS u32x4*)(Ktw + tid * 72 + 8 * i); sum += bflo(w.x) + bfhi(w.x) + bflo(w.y) + bfhi(w.y) + bflo(w.z) + bfhi(w.z) + bflo(w.w) + bfhi(w.w); }
            dn_acc += sum; }
#pragma unroll 1
        for (int ks = 0; ks < 2; ++ks) { bf16x8 A[2];
#pragma unroll
            for (int mt = 0; mt < 2; ++mt) A[mt] = *(LAS bf16x8*)(Vts + (32 * wid + 16 * mt + r) * 72 + 32 * ks + 8 * q);
#pragma unroll
            for (int nt = 0; nt < 8; ++nt) { const bf16x8 B = *(LAS bf16x8*)(Ktw + (16 * nt + r) * 72 + 32 * ks + 8 * q);
                acc[0][nt] = MFMA16(B, A[0], acc[0][nt]); acc[1][nt] = MFMA16(B, A[1], acc[1][nt]); } }
        __syncthreads();
    }
    bf16_t* DC = (bf16_t*)(p.ws + WS_DC) + (size_t)sidx * 32768;
#pragma unroll
    for (int mt = 0; mt < 2; ++mt)
#pragma unroll
        for (int nt = 0; nt < 8; ++nt) { u32x2 w; w.x = pk2(acc[mt][nt][0], acc[mt][nt][1]); w.y = pk2(acc[mt][nt][2], acc[mt][nt][3]);
            *(u32x2*)(DC + (32 * wid + 16 * mt + r) * 128 + 16 * nt + 4 * q) = w; }
    if (tid < 128) ((float*)(p.ws + WS_DN))[(size_t)sidx * 128 + tid] = dn_acc;
}

DI void phase_m2(const Params& p) {
    const float* JS = (const float*)(p.ws + WS_JS); const bf16_t* DC = (const bf16_t*)(p.ws + WS_DC); const float* DN = (const float*)(p.ws + WS_DN);
    bf16_t* CIN = (bf16_t*)(p.ws + WS_CIN); float* NIN = (float*)(p.ws + WS_NIN); float* MIN_ = (float*)(p.ws + WS_MIN);
    for (int item = lbid() * 512 + ltid(); item < 131072 + 512; item += gridDim.x * 512) {
        const bool isn = item >= 131072; int chain, off;
        if (!isn) { chain = item >> 13; off = (item & 8191) * 4; } else { const int it = item - 131072; chain = it >> 5; off = (it & 31) * 4; }
        const int dir = chain & 1;
        float4 C = make_float4(0.f, 0.f, 0.f, 0.f); float m = -1e30f;
#pragma unroll
        for (int step = 0; step < 17; ++step) {
            const int J = step == 0 ? 0 : (dir ? 17 - step : step), sidx = chain * 17 + J;
            if (!isn) { u32x2 w; w.x = pk2(C.x, C.y); w.y = pk2(C.z, C.w); *(u32x2*)(CIN + (size_t)sidx * 32768 + off) = w; if (off == 0) MIN_[sidx] = m; }
            else *(float4*)(NIN + (size_t)sidx * 128 + off) = C;
            const float Bt = JS[sidx * 2], ml = JS[sidx * 2 + 1], mn = fmaxf(Bt + m, ml), a = __expf(Bt + m - mn), bb = __expf(ml - mn);
            float4 d;
            if (isn) d = *(const float4*)(DN + (size_t)sidx * 128 + off);
            else { const u32x2 w = *(const u32x2*)(DC + (size_t)sidx * 32768 + off); d = make_float4(bflo(w.x), bfhi(w.x), bflo(w.y), bfhi(w.y)); }
            C.x = a * C.x + bb * d.x; C.y = a * C.y + bb * d.y; C.z = a * C.z + bb * d.z; C.w = a * C.w + bb * d.w; m = mn;
        }
    }
}

DI void m3_task(LAS unsigned char* lds, const Params& p, int l, int task) {
    const int tb = task & 3, J = (task >> 2) % 17, bh = (task >> 2) / 17, b = bh >> 2, h = bh & 3;
    const int tid = ltid(), wid = tid >> 6, lane = tid & 63, r = lane & 15, q = lane >> 4;
    LAS bf16_t* Qs = (LAS bf16_t*)lds;
    LAS bf16_t* Ks = (LAS bf16_t*)(lds + 17408);
    LAS bf16_t* Vts = (LAS bf16_t*)(lds + 34816);
    LAS bf16_t* Ps = (LAS bf16_t*)(lds + 71680);
    LAS float* es = (LAS float*)(lds + 80896);
    LAS float* Mt = (LAS float*)(lds + 81920); LAS float* inter = (LAS float*)(lds + 82176); LAS float* dfl = (LAS float*)(lds + 82432);
    LAS float* nqi = (LAS float*)(lds + 82688); LAS float* dinv = (LAS float*)(lds + 82944); LAS float* rinv = (LAS float*)(lds + 83200);
    LAS float* rs2 = (LAS float*)(lds + 83456);
    LAS float* ssq = (LAS float*)(lds + 83968);
    const bf16_t* QC = (const bf16_t*)(p.ws + WS_QC); const bf16_t* KC = (const bf16_t*)(p.ws + WS_KC); const bf16_t* VT = (const bf16_t*)(p.ws + WS_VT);
    const float* EG = (const float*)(p.ws + WS_EG); const float* BG = (const float*)(p.ws + WS_BG);
    { const int t = tid >> 3, part = tid & 7; const bf16_t* src = QC + ((size_t)bh * 4352 + J * 256 + tb * 64 + t) * 128 + part * 16;
      *(LAS u32x4*)(Qs + t * 136 + part * 16) = *(const u32x4*)src; *(LAS u32x4*)(Qs + t * 136 + part * 16 + 8) = *(const u32x4*)(src + 8); }
    f32x4 H[4][2];
#pragma unroll
    for (int a = 0; a < 4; ++a) { H[a][0] = (f32x4){0.f, 0.f, 0.f, 0.f}; H[a][1] = (f32x4){0.f, 0.f, 0.f, 0.f}; }
#pragma unroll 1
    for (int dir = 0; dir < 2; ++dir) {
        const int chain = bh * 2 + dir, sidx = chain * 17 + J;
        const float m_in = ((const float*)(p.ws + WS_MIN))[sidx];
        const int sb_lo = dir == 0 ? 0 : tb, sb_hi = dir == 0 ? tb : 3;
        u32x4 kr[2], vr[4];
#define M3_LOADKV(sbx) do { const bf16_t* ksrc = KC + ((size_t)bh * 4352 + J * 256 + (sbx) * 64 + (tid >> 3)) * 128 + (tid & 7) * 16; kr[0] = *(const u32x4*)ksrc; kr[1] = *(const u32x4*)(ksrc + 8); \
        const bf16_t* vsrc = VT + ((((size_t)bh * 17 + J) * 4 + (sbx)) * 256 + (tid >> 1)) * 64 + (tid & 1) * 32; vr[0] = *(const u32x4*)vsrc; vr[1] = *(const u32x4*)(vsrc + 8); vr[2] = *(const u32x4*)(vsrc + 16); vr[3] = *(const u32x4*)(vsrc + 24); } while (0)
        M3_LOADKV(sb_lo);
        if (tid < 256) es[tid] = EG[(size_t)chain * 4352 + J * 256 + tid];
        float bgv = 0.f; if (tid < 64) bgv = BG[(size_t)chain * 4352 + J * 256 + tb * 64 + tid];
        float4 nv[4]; { const float* nin = (const float*)(p.ws + WS_NIN) + (size_t)sidx * 128 + (tid & 7) * 16;
#pragma unroll
            for (int i = 0; i < 4; ++i) nv[i] = *(const float4*)(nin + 4 * i); }
        __syncthreads();
        if (tid < 64) { const int T = tb * 64 + tid; float v = es[T], oth = -3e38f;
            if (dir == 0) {
#pragma unroll
                for (int o = 1; o < 64; o <<= 1) { const float t2 = __shfl_up(v, o); if (lane >= o) v = fmaxf(v, t2); }
                for (int k = 0; k < tb; ++k) oth = fmaxf(oth, es[k * 64 + lane]);
            } else {
#pragma unroll
                for (int o = 1; o < 64; o <<= 1) { const float t2 = __shfl_down(v, o); if (lane + o < 64) v = fmaxf(v, t2); }
                for (int k = tb + 1; k < 4; ++k) oth = fmaxf(oth, es[k * 64 + lane]);
            }
#pragma unroll
            for (int o = 32; o; o >>= 1) oth = fmaxf(oth, shx(oth, o));
            const float pm = fmaxf(v, oth);
            const float M = fmaxf(m_in, pm); Mt[tid] = M; inter[tid] = __expf(m_in - M);
            dfl[tid] = __expf(-(bgv + M)); }
        { const int t = tid >> 3, part = tid & 7; float s = 0.f;
#pragma unroll
          for (int i = 0; i < 4; ++i) { const u32x2 qw = *(LAS u32x2*)(Qs + t * 136 + part * 16 + 4 * i);
              s += bflo(qw.x) * nv[i].x + bfhi(qw.x) * nv[i].y + bflo(qw.y) * nv[i].z + bfhi(qw.y) * nv[i].w; }
          s += shx(s, 1); s += shx(s, 2); s += shx(s, 4); if (part == 0) nqi[t] = s; }
        __syncthreads();
        f32x4 O[4][2];
#pragma unroll
        for (int a = 0; a < 4; ++a) { O[a][0] = (f32x4){0.f, 0.f, 0.f, 0.f}; O[a][1] = (f32x4){0.f, 0.f, 0.f, 0.f}; }
        { const bf16_t* Cg = (const bf16_t*)(p.ws + WS_CIN) + (size_t)sidx * 32768;
#pragma unroll
          for (int ks = 0; ks < 4; ++ks) { bf16x8 Bf[2];
#pragma unroll
              for (int nt = 0; nt < 2; ++nt) Bf[nt] = *(const bf16x8*)(Cg + (size_t)(32 * wid + 16 * nt + r) * 128 + 32 * ks + 8 * q);
#pragma unroll
              for (int mt = 0; mt < 4; ++mt) { const bf16x8 A = *(LAS bf16x8*)(Qs + (16 * mt + r) * 136 + 32 * ks + 8 * q); O[mt][0] = MFMA16(Bf[0], A, O[mt][0]); O[mt][1] = MFMA16(Bf[1], A, O[mt][1]); } }
#pragma unroll
          for (int mt = 0; mt < 4; ++mt) { const float it = inter[16 * mt + r]; O[mt][0] *= it; O[mt][1] *= it; } }
        float rsum[4] = {0.f, 0.f, 0.f, 0.f};
#pragma unroll 1
        for (int sb = sb_lo; sb <= sb_hi; ++sb) {
            { const int t = tid >> 3, part = tid & 7; *(LAS u32x4*)(Ks + t * 136 + part * 16) = kr[0]; *(LAS u32x4*)(Ks + t * 136 + part * 16 + 8) = kr[1]; }
            { const int v = tid >> 1, half = tid & 1;
#pragma unroll
              for (int i = 0; i < 4; ++i) *(LAS u32x4*)(Vts + v * 72 + half * 32 + 8 * i) = vr[i]; }
            __syncthreads();
            if (sb < sb_hi) M3_LOADKV(sb + 1);
            { const int mt = wid & 3, ntb = (wid >> 2) * 2; f32x4 S[2]; S[0] = (f32x4){0.f, 0.f, 0.f, 0.f}; S[1] = S[0];
#pragma unroll
              for (int ks = 0; ks < 4; ++ks) { const bf16x8 A = *(LAS bf16x8*)(Qs + (16 * mt + r) * 136 + 32 * ks + 8 * q);
#pragma unroll
                  for (int n2 = 0; n2 < 2; ++n2) { const bf16x8 B = *(LAS bf16x8*)(Ks + (16 * (ntb + n2) + r) * 136 + 32 * ks + 8 * q); S[n2] = MFMA16(A, B, S[n2]); } }
#pragma unroll
              for (int n2 = 0; n2 < 2; ++n2)
#pragma unroll
                  for (int j = 0; j < 4; ++j) { const int t = 16 * mt + 4 * q + j, s = 16 * (ntb + n2) + r, Tg = tb * 64 + t, Sg = sb * 64 + s;
                      const bool ok = dir == 0 ? (Sg <= Tg) : (Sg >= Tg);
                      const float pv = ok ? S[n2][j] * __expf(fminf(es[Sg] - Mt[t], 0.f)) : 0.f;
                      rsum[j] += pv; Ps[t * 72 + s] = (bf16_t)f2bf(pv); } }
            __syncthreads();
#pragma unroll
            for (int ks = 0; ks < 2; ++ks) { bf16x8 Bf[2];
#pragma unroll
                for (int nt = 0; nt < 2; ++nt) Bf[nt] = *(LAS bf16x8*)(Vts + (32 * wid + 16 * nt + r) * 72 + 32 * ks + 8 * q);
#pragma unroll
                for (int mt = 0; mt < 4; ++mt) { const bf16x8 A = *(LAS bf16x8*)(Ps + (16 * mt + r) * 72 + 32 * ks + 8 * q); O[mt][0] = MFMA16(Bf[0], A, O[mt][0]); O[mt][1] = MFMA16(Bf[1], A, O[mt][1]); } }
            __syncthreads();
        }
#pragma unroll
        for (int j = 0; j < 4; ++j) { float v = rsum[j]; v += shx(v, 1); v += shx(v, 2); v += shx(v, 4); v += shx(v, 8);
            if (r == 0) rs2[(16 * (wid & 3) + 4 * q + j) * 2 + (wid >> 2)] = v; }
        __syncthreads();
        if (tid < 64) { const float nq = inter[tid] * nqi[tid] + rs2[2 * tid] + rs2[2 * tid + 1]; dinv[tid] = 1.f / fmaxf(fabsf(nq), dfl[tid]); }
        __syncthreads();
#pragma unroll
        for (int mt = 0; mt < 4; ++mt) { const float di = dinv[16 * mt + r]; H[mt][0] += O[mt][0] * di; H[mt][1] += O[mt][1] * di; }
        __syncthreads();
    }
#pragma unroll
    for (int mt = 0; mt < 4; ++mt) { float v = 0.f;
#pragma unroll
        for (int j = 0; j < 4; ++j) v += H[mt][0][j] * H[mt][0][j] + H[mt][1][j] * H[mt][1][j];
        v += shx(v, 16); v += shx(v, 32);
        if (q == 0) ssq[(16 * mt + r) * 8 + wid] = v; }
    __syncthreads();
    if (tid < 64) { float s = 0.f;
#pragma unroll
        for (int w = 0; w < 8; ++w) s += ssq[tid * 8 + w];
        rinv[tid] = rsqrtf(s * (1.f / 256.f) + 1e-6f); }
    __syncthreads();
    const bf16_t* P = (const bf16_t*)(p.ws + WS_P); bf16_t* Y = (bf16_t*)(p.ws + WS_Y);
#pragma unroll
    for (int mt = 0; mt < 4; ++mt) { const int t = 16 * mt + r; const size_t row = (size_t)pos_row(b, J * 256 + tb * 64 + t); const float ri = rinv[t];
#pragma unroll
        for (int nt = 0; nt < 2; ++nt) { const int col = h * 256 + 32 * wid + 16 * nt + 4 * q;
            const u32x2 ow = *(const u32x2*)(P + row * NPC + 2048 + col), zw = *(const u32x2*)(P + row * NPC + 3072 + col); const float4 gn = *(const float4*)(p.mng + l * 1024 + col);
            const float o0 = bflo(ow.x), o1 = bfhi(ow.x), o2 = bflo(ow.y), o3 = bfhi(ow.y), z0 = bflo(zw.x), z1 = bfhi(zw.x), z2 = bflo(zw.y), z3 = bfhi(zw.y);
            u32x2 yw; yw.x = pk2(H[mt][nt][0] * ri * gn.x * sigm(o0) * z0 * sigm(z0), H[mt][nt][1] * ri * gn.y * sigm(o1) * z1 * sigm(z1));
            yw.y = pk2(H[mt][nt][2] * ri * gn.z * sigm(o2) * z2 * sigm(z2), H[mt][nt][3] * ri * gn.w * sigm(o3) * z3 * sigm(z3));
            *(u32x2*)(Y + row * 2048 + col) = yw; } }
    __syncthreads();
}

DI void r_task(LAS unsigned char* lds, const Params& p, int l, int task, int mode, const int d0 = 0, const int d1 = 2) {
    const int g = task & 15, seg = task >> 4;
    const int tid = ltid(), wid = tid >> 6, lane = tid & 63, r = lane & 15, q = lane >> 4;
    int b, base_row, tok0, seqlen, s16 = 0;
    if (seg < 2) { b = seg; base_row = 8192 + b * 256; tok0 = 0; seqlen = 256; } else { const int si = seg - 2; b = si >> 4; s16 = si & 15; base_row = b * 4096; tok0 = s16 * 256; seqlen = 4096; }
    LAS float* xcf = (LAS float*)lds;
    LAS bf16_t* xcb = (LAS bf16_t*)(lds + 66560);
    LAS float* wagg = (LAS float*)(lds + 103424);
    LAS float* hin = (LAS float*)(lds + 107520);
    const bf16_t* P = (const bf16_t*)(p.ws + WS_P);
    if (mode == 0) { const int t = tid & 255, half = __builtin_amdgcn_readfirstlane(tid >> 8), cb = 64 * g + half * 32;
      float a[32];
#pragma unroll
      for (int i = 0; i < 32; i += 4) { const float4 bb = *(const float4*)(p.crb + l * 1024 + cb + i); a[i] = bb.x; a[i + 1] = bb.y; a[i + 2] = bb.z; a[i + 3] = bb.w; }
#pragma unroll
      for (int j = 0; j < 4; ++j) { const int tk = tok0 + t - 1 + j;
          if (tk >= 0 && tk < seqlen) { const bf16_t* src = P + (size_t)(base_row + tk) * NPC + 4096 + cb; const float* wp = p.crw + (size_t)(l * 4 + j) * 1024 + cb;
#pragma unroll
              for (int i8 = 0; i8 < 4; ++i8) { const u32x4 w = *(const u32x4*)(src + 8 * i8); const float4 w0 = *(const float4*)(wp + 8 * i8), w1 = *(const float4*)(wp + 8 * i8 + 4);
                  a[8 * i8 + 0] += w0.x * bflo(w.x); a[8 * i8 + 1] += w0.y * bfhi(w.x); a[8 * i8 + 2] += w0.z * bflo(w.y); a[8 * i8 + 3] += w0.w * bfhi(w.y);
                  a[8 * i8 + 4] += w1.x * bflo(w.z); a[8 * i8 + 5] += w1.y * bfhi(w.z); a[8 * i8 + 6] += w1.z * bflo(w.w); a[8 * i8 + 7] += w1.w * bfhi(w.w); } } }
#pragma unroll
      for (int i = 0; i < 32; ++i) xcf[t * 65 + half * 32 + i] = a[i];
#pragma unroll
      for (int i8 = 0; i8 < 4; ++i8) { u32x4 w; w.x = pk2(a[8 * i8], a[8 * i8 + 1]); w.y = pk2(a[8 * i8 + 2], a[8 * i8 + 3]); w.z = pk2(a[8 * i8 + 4], a[8 * i8 + 5]); w.w = pk2(a[8 * i8 + 6], a[8 * i8 + 7]);
          *(LAS u32x4*)(xcb + t * 72 + half * 32 + 8 * i8) = w; } }
    __syncthreads();
    f32x4 Hs[2][4];
#pragma unroll
    for (int a = 0; a < 2; ++a)
#pragma unroll
        for (int n = 0; n < 4; ++n) Hs[a][n] = (f32x4){0.f, 0.f, 0.f, 0.f};
    const float2* RA = (const float2*)(p.ws + WS_RAGG);
#pragma unroll 1
    for (int dir = d0; dir < d1; ++dir) {
        if (mode == 1 && tid < 64) { float hh = 0.f;
            if (seg >= 2) { float2 au[17]; au[0] = RA[((size_t)b * 2 + dir) * 1024 + 64 * g + tid];
#pragma unroll
                for (int k = 0; k < 16; ++k) { const int sk = dir == 0 ? k : 15 - k; const bool use = dir == 0 ? (sk < s16) : (sk > s16);
                    au[1 + k] = use ? RA[((size_t)(2 + b * 16 + sk) * 2 + dir) * 1024 + 64 * g + tid] : make_float2(1.f, 0.f); }
#pragma unroll
                for (int k = 0; k < 17; ++k) hh = au[k].x * hh + au[k].y; }
            hin[tid] = hh; }
        const bf16_t* Wr = (const bf16_t*)(p.ws + WS_WRT) + ((size_t)((l * 2 + dir) * 2 + 0) * 16 + g) * 4096; const bf16_t* Wi = Wr + (size_t)16 * 4096;
        unsigned* LU = (unsigned*)(p.ws + WS_LU) + ((size_t)dir * NTOK + base_row + tok0) * 1024 + 64 * g;
        f32x4 R[2][4], I[2][4];
        if (mode == 1) {
#pragma unroll
            for (int mt = 0; mt < 2; ++mt)
#pragma unroll
                for (int nt = 0; nt < 4; ++nt)
#pragma unroll
                    for (int j = 0; j < 4; ++j) { const unsigned w = LU[(size_t)(32 * wid + 16 * mt + 4 * q + j) * 1024 + 16 * nt + r]; R[mt][nt][j] = __builtin_amdgcn_exp2f(bflo(w)); I[mt][nt][j] = bfhi(w); }
        } else {
#pragma unroll
        for (int a = 0; a < 2; ++a)
#pragma unroll
            for (int n = 0; n < 4; ++n) { R[a][n] = (f32x4){0.f, 0.f, 0.f, 0.f}; I[a][n] = (f32x4){0.f, 0.f, 0.f, 0.f}; }
#pragma unroll
        for (int ks = 0; ks < 2; ++ks) { bf16x8 A[2];
#pragma unroll
            for (int mt = 0; mt < 2; ++mt) A[mt] = *(LAS bf16x8*)(xcb + (32 * wid + 16 * mt + r) * 72 + 32 * ks + 8 * q);
#pragma unroll
            for (int nt = 0; nt < 4; ++nt) { const bf16x8 br = *(const bf16x8*)(Wr + (16 * nt + r) * 64 + 32 * ks + 8 * q), bi = *(const bf16x8*)(Wi + (16 * nt + r) * 64 + 32 * ks + 8 * q);
                R[0][nt] = MFMA16(A[0], br, R[0][nt]); R[1][nt] = MFMA16(A[1], br, R[1][nt]); I[0][nt] = MFMA16(A[0], bi, I[0][nt]); I[1][nt] = MFMA16(A[1], bi, I[1][nt]); } }
#pragma unroll
        for (int nt = 0; nt < 4; ++nt) { const int ch = 64 * g + 16 * nt + r;
            const float br = p.b_rg[(size_t)((l * 2 + dir) * 2 + 0) * 1024 + ch], bi = p.b_rg[(size_t)((l * 2 + dir) * 2 + 1) * 1024 + ch], lm = p.lam[(size_t)(l * 2 + dir) * 1024 + ch];
            const float sp = fmaxf(-lm, 0.f) + __logf(1.f + __expf(-fabsf(lm)));
            const float nbr = -1.4426950408889634f * br, nbi = -1.4426950408889634f * bi, c2 = -8.f * 1.4426950408889634f * sp, ct = 16.f * sp;
#pragma unroll
            for (int mt = 0; mt < 2; ++mt)
#pragma unroll
                for (int j = 0; j < 4; ++j) { const int t = 32 * wid + 16 * mt + 4 * q + j;
                    const float d1 = 1.f + __builtin_amdgcn_exp2f(fminf(__builtin_fmaf(R[mt][nt][j], -1.4426950408889634f, nbr), 43.f));
                    const float d2 = 1.f + __builtin_amdgcn_exp2f(fminf(__builtin_fmaf(I[mt][nt][j], -1.4426950408889634f, nbi), 43.f));
                    const float rc = __builtin_amdgcn_rcpf(d1 * d2), rr = d2 * rc, ii = d1 * rc, la2 = rr * c2, a = __builtin_amdgcn_exp2f(la2), tt = rr * ct;
                    const float om = tt < 1e-3f ? tt * (1.f - 0.5f * tt) : __builtin_fmaf(-a, a, 1.f);
                    const float uu = __builtin_amdgcn_sqrtf(om) * ii * xcf[t * 65 + 16 * nt + r];
                    R[mt][nt][j] = a; I[mt][nt][j] = uu; LU[(size_t)t * 1024 + 16 * nt + r] = pk2(la2, uu); } }
        }
        float pA[2][4], pU[2][4], tA[2][4], tU[2][4];
#pragma unroll
        for (int mt = 0; mt < 2; ++mt)
#pragma unroll
            for (int nt = 0; nt < 4; ++nt) { const f32x4 a = R[mt][nt], u = I[mt][nt]; float A_, U_;
                if (dir == 0) { A_ = a[0] * a[1] * a[2] * a[3]; U_ = ((u[0] * a[1] + u[1]) * a[2] + u[2]) * a[3] + u[3]; }
                else { A_ = a[0] * a[1] * a[2] * a[3]; U_ = ((u[3] * a[2] + u[2]) * a[1] + u[1]) * a[0] + u[0]; }
                float Ak[4], Uk[4];
#pragma unroll
                for (int k = 0; k < 4; ++k) { Ak[k] = __shfl(A_, r + 16 * k); Uk[k] = __shfl(U_, r + 16 * k); }
                float PA = 1.f, PU = 0.f, TA = 1.f, TU = 0.f;
                if (dir == 0) {
#pragma unroll
                    for (int k = 0; k < 4; ++k) { if (k < q) { PU = PU * Ak[k] + Uk[k]; PA *= Ak[k]; } TU = TU * Ak[k] + Uk[k]; TA *= Ak[k]; }
                } else {
#pragma unroll
                    for (int k = 3; k >= 0; --k) { if (k > q) { PU = PU * Ak[k] + Uk[k]; PA *= Ak[k]; } TU = TU * Ak[k] + Uk[k]; TA *= Ak[k]; }
                }
                pA[mt][nt] = PA; pU[mt][nt] = PU; tA[mt][nt] = TA; tU[mt][nt] = TU; }
#pragma unroll
        for (int nt = 0; nt < 4; ++nt) {
            const float WA = tA[0][nt] * tA[1][nt], WU = dir == 0 ? tU[0][nt] * tA[1][nt] + tU[1][nt] : tU[1][nt] * tA[0][nt] + tU[0][nt];
            if (q == 0) { wagg[(wid * 2 + 0) * 64 + 16 * nt + r] = WA; wagg[(wid * 2 + 1) * 64 + 16 * nt + r] = WU; } }
        __syncthreads();
        if (mode == 0) {
            if (tid < 64) { float A_ = 1.f, U_ = 0.f;
#pragma unroll
                for (int kk = 0; kk < 8; ++kk) { const int w = dir == 0 ? kk : 7 - kk; const float a = wagg[(w * 2 + 0) * 64 + tid], u = wagg[(w * 2 + 1) * 64 + tid]; U_ = U_ * a + u; A_ *= a; }
                ((float2*)(p.ws + WS_RAGG))[((size_t)seg * 2 + dir) * 1024 + 64 * g + tid] = make_float2(A_, U_); }
        } else {
#pragma unroll
            for (int nt = 0; nt < 4; ++nt) { float hh = hin[16 * nt + r];
                if (dir == 0) { for (int w = 0; w < wid; ++w) hh = wagg[(w * 2 + 0) * 64 + 16 * nt + r] * hh + wagg[(w * 2 + 1) * 64 + 16 * nt + r]; }
                else { for (int w = 7; w > wid; --w) hh = wagg[(w * 2 + 0) * 64 + 16 * nt + r] * hh + wagg[(w * 2 + 1) * 64 + 16 * nt + r]; }
                if (dir == 0) {
#pragma unroll
                    for (int mt = 0; mt < 2; ++mt) { float hv = pA[mt][nt] * hh + pU[mt][nt];
#pragma unroll
                        for (int j = 0; j < 4; ++j) { hv = R[mt][nt][j] * hv + I[mt][nt][j]; Hs[mt][nt][j] += hv; }
                        hh = tA[mt][nt] * hh + tU[mt][nt]; }
                } else {
#pragma unroll
                    for (int mt = 1; mt >= 0; --mt) { float hv = pA[mt][nt] * hh + pU[mt][nt];
#pragma unroll
                        for (int j = 3; j >= 0; --j) { hv = R[mt][nt][j] * hv + I[mt][nt][j]; Hs[mt][nt][j] += hv; }
                        hh = tA[mt][nt] * hh + tU[mt][nt]; }
                } }
        }
        __syncthreads();
    }
    if (mode == 1) { bf16_t* Y = (bf16_t*)(p.ws + WS_Y);
#pragma unroll
        for (int mt = 0; mt < 2; ++mt)
#pragma unroll
            for (int nt = 0; nt < 4; ++nt)
#pragma unroll
                for (int j = 0; j < 4; ++j) { const size_t row = (size_t)(base_row + tok0 + 32 * wid + 16 * mt + 4 * q + j); const int ch = 64 * g + 16 * nt + r;
                    const float z = bf2f(P[row * NPC + 5120 + ch]); Y[row * 2048 + 1024 + ch] = (bf16_t)f2bf(Hs[mt][nt][j] * z * sigm(z)); } }
    __syncthreads();
}

#if SINGLE_LAUNCH

DI void r0s_task(LAS unsigned char* lds, const Params& p, int l, int task) {
    const int g = task & 15, seg = task >> 4;
    const int tid = ltid(), wid = tid >> 6, lane = tid & 63, r = lane & 15, q = lane >> 4;
    int b, base_row, tok0, seqlen;
    if (seg < 2) { b = seg; base_row = 8192 + b * 256; tok0 = 0; seqlen = 256; } else { const int si = seg - 2; b = si >> 4; base_row = b * 4096; tok0 = (si & 15) * 256; seqlen = 4096; }
    LAS float* xcf = (LAS float*)lds;
    LAS bf16_t* GR = (LAS bf16_t*)(lds + 69632);
    LAS bf16_t* GI = (LAS bf16_t*)(lds + 69632 + 32768);
    LAS float* agg = (LAS float*)(lds + 69632 + 65536);
    const bf16_t* P = (const bf16_t*)(p.ws + WS_P);
    { const int t = tid >> 1, half = tid & 1, cb = 64 * g + half * 32;
      float a[32];
#pragma unroll
      for (int i = 0; i < 32; i += 4) { const float4 bb = *(const float4*)(p.crb + l * 1024 + cb + i); a[i] = bb.x; a[i + 1] = bb.y; a[i + 2] = bb.z; a[i + 3] = bb.w; }
#pragma unroll
      for (int j = 0; j < 4; ++j) { const int tk = tok0 + t - 1 + j;
          if (tk >= 0 && tk < seqlen) { const bf16_t* src = P + (size_t)(base_row + tk) * NPC + 4096 + cb; const float* wp = p.crw + (size_t)(l * 4 + j) * 1024 + cb;
#pragma unroll
              for (int i8 = 0; i8 < 4; ++i8) { const u32x4 w = *(const u32x4*)(src + 8 * i8); const float4 w0 = *(const float4*)(wp + 8 * i8), w1 = *(const float4*)(wp + 8 * i8 + 4);
                  a[8 * i8 + 0] += w0.x * bflo(w.x); a[8 * i8 + 1] += w0.y * bfhi(w.x); a[8 * i8 + 2] += w0.z * bflo(w.y); a[8 * i8 + 3] += w0.w * bfhi(w.y);
                  a[8 * i8 + 4] += w1.x * bflo(w.z); a[8 * i8 + 5] += w1.y * bfhi(w.z); a[8 * i8 + 6] += w1.z * bflo(w.w); a[8 * i8 + 7] += w1.w * bfhi(w.w); } } }
#pragma unroll
      for (int i = 0; i < 32; i += 4) *(LAS f32x4*)(xcf + t * 68 + half * 32 + i) = (f32x4){a[i], a[i + 1], a[i + 2], a[i + 3]}; }
    __syncthreads();
    bf16x8 Af[2][2];
#pragma unroll
    for (int ks = 0; ks < 2; ++ks)
#pragma unroll
        for (int mt = 0; mt < 2; ++mt) { const LAS float* src = xcf + (32 * wid + 16 * mt + r) * 68 + 32 * ks + 8 * q; const f32x4 x0 = *(const LAS f32x4*)src, x1 = *(const LAS f32x4*)(src + 4);
            u32x4 w; w.x = pk2(x0[0], x0[1]); w.y = pk2(x0[2], x0[3]); w.z = pk2(x1[0], x1[1]); w.w = pk2(x1[2], x1[3]); Af[ks][mt] = __builtin_bit_cast(bf16x8, w); }
#pragma unroll 1
    for (int dir = 0; dir < 2; ++dir) {
        const bf16_t* Wr = (const bf16_t*)(p.ws + WS_WRT) + ((size_t)((l * 2 + dir) * 2 + 0) * 16 + g) * 4096; const bf16_t* Wi = Wr + (size_t)16 * 4096;
        { f32x4 R[2][4], I[2][4];
#pragma unroll
          for (int a = 0; a < 2; ++a)
#pragma unroll
              for (int n = 0; n < 4; ++n) { R[a][n] = (f32x4){0.f, 0.f, 0.f, 0.f}; I[a][n] = (f32x4){0.f, 0.f, 0.f, 0.f}; }
#pragma unroll
          for (int ks = 0; ks < 2; ++ks)
#pragma unroll
              for (int nt = 0; nt < 4; ++nt) { const bf16x8 br = *(const bf16x8*)(Wr + (16 * nt + r) * 64 + 32 * ks + 8 * q), bi = *(const bf16x8*)(Wi + (16 * nt + r) * 64 + 32 * ks + 8 * q);
                  R[0][nt] = MFMA16(Af[ks][0], br, R[0][nt]); R[1][nt] = MFMA16(Af[ks][1], br, R[1][nt]); I[0][nt] = MFMA16(Af[ks][0], bi, I[0][nt]); I[1][nt] = MFMA16(Af[ks][1], bi, I[1][nt]); }
#pragma unroll
          for (int mt = 0; mt < 2; ++mt)
#pragma unroll
              for (int nt = 0; nt < 4; ++nt)
#pragma unroll
                  for (int j = 0; j < 4; ++j) { const int o = (32 * wid + 16 * mt + 4 * q + j) * 64 + 16 * nt + r; GR[o] = (bf16_t)f2bf(R[mt][nt][j]); GI[o] = (bf16_t)f2bf(I[mt][nt][j]); } }
        __syncthreads();
        { const int c = lane, ch = 64 * g + c;
          const float br = p.b_rg[(size_t)((l * 2 + dir) * 2 + 0) * 1024 + ch], bi = p.b_rg[(size_t)((l * 2 + dir) * 2 + 1) * 1024 + ch], lm = p.lam[(size_t)(l * 2 + dir) * 1024 + ch];
          const float sp = fmaxf(-lm, 0.f) + __logf(1.f + __expf(-fabsf(lm)));
          unsigned* LU = (unsigned*)(p.ws + WS_LU) + ((size_t)dir * NTOK + base_row + tok0) * 1024 + ch;
          float Aa = 1.f, Uu = 0.f;
#pragma unroll 4
          for (int i = 0; i < 32; ++i) { const int t = 32 * wid + (dir == 0 ? i : 31 - i);
              const float d1 = 1.f + __expf(-fmaxf(bf2f(GR[t * 64 + c]) + br, -30.f)), d2 = 1.f + __expf(-fmaxf(bf2f(GI[t * 64 + c]) + bi, -30.f)), rc = __builtin_amdgcn_rcpf(d1 * d2);
              const float rr = d2 * rc, ii = d1 * rc, la = -8.f * rr * sp, a = __expf(la);
              const float uu = __builtin_amdgcn_sqrtf(one_m_expneg(-2.f * la, a * a)) * ii * xcf[t * 68 + c];
              LU[(size_t)t * 1024] = pk2(la, uu);
              Uu = Uu * a + uu; Aa *= a; }
          agg[(wid * 2 + 0) * 64 + c] = Aa; agg[(wid * 2 + 1) * 64 + c] = Uu; }
        __syncthreads();
        if (tid < 64) { float A_ = 1.f, U_ = 0.f;
#pragma unroll
            for (int kk = 0; kk < 8; ++kk) { const int w = dir == 0 ? kk : 7 - kk; const float a = agg[(w * 2 + 0) * 64 + tid], u = agg[(w * 2 + 1) * 64 + tid]; U_ = U_ * a + u; A_ *= a; }
            ((float2*)(p.ws + WS_RAGG))[((size_t)seg * 2 + dir) * 1024 + 64 * g + tid] = make_float2(A_, U_); }
        __syncthreads();
    }
}

DI void rs_task(LAS unsigned char* lds, const Params& p, int l, int task) {
    const int cg4 = task & 3, seg = task >> 2;
    const int tid = ltid();
    int b, base_row, tok0, s16 = 0;
    if (seg < 2) { b = seg; base_row = 8192 + b * 256; tok0 = 0; } else { const int si = seg - 2; b = si >> 4; s16 = si & 15; base_row = b * 4096; tok0 = s16 * 256; }
    LAS bf16_t* Hs = (LAS bf16_t*)lds;
    const int c = tid & 255, dir = tid >> 8, ch = 256 * cg4 + c;
    float h = 0.f;
    { const float2* RA = (const float2*)(p.ws + WS_RAGG);
      if (seg >= 2) { float2 au[17]; au[0] = RA[((size_t)b * 2 + dir) * 1024 + ch];
#pragma unroll
          for (int k = 0; k < 16; ++k) { const int sk = dir == 0 ? k : 15 - k; const bool use = dir == 0 ? (sk < s16) : (sk > s16);
              au[1 + k] = use ? RA[((size_t)(2 + b * 16 + sk) * 2 + dir) * 1024 + ch] : make_float2(1.f, 0.f); }
#pragma unroll
          for (int k = 0; k < 17; ++k) h = au[k].x * h + au[k].y; } }
    const unsigned* LU = (const unsigned*)(p.ws + WS_LU) + ((size_t)dir * NTOK + base_row + tok0) * 1024 + ch;
    LAS bf16_t* Hd = Hs + c;
    unsigned wa[32], wb[32];
#define RS_LOAD(dst, s0) _Pragma("unroll") for (int i = 0; i < 32; ++i) { const int t = dir == 0 ? (s0) + i : 255 - (s0) - i; dst[i] = LU[(size_t)t * 1024]; }
#define RS_SCAN(src, s0, ADD) _Pragma("unroll") for (int i = 0; i < 32; ++i) { const int t = dir == 0 ? (s0) + i : 255 - (s0) - i; h = __builtin_amdgcn_exp2f(bflo(src[i])) * h + bfhi(src[i]); \
        const float o_ = ADD ? h + bf2f(Hd[t * 256]) : h; Hd[t * 256] = (bf16_t)f2bf(o_); }
    RS_LOAD(wa, 0)
#pragma unroll 1
    for (int s0 = 0; s0 < 128; s0 += 64) { RS_LOAD(wb, s0 + 32) RS_SCAN(wa, s0, false) RS_LOAD(wa, s0 + 64) RS_SCAN(wb, s0 + 32, false) }
    __syncthreads();
#pragma unroll 1
    for (int s0 = 128; s0 < 256; s0 += 64) { RS_LOAD(wb, s0 + 32) RS_SCAN(wa, s0, true) if (s0 + 64 < 256) { RS_LOAD(wa, s0 + 64) } RS_SCAN(wb, s0 + 32, true) }
    __syncthreads();
    const bf16_t* P = (const bf16_t*)(p.ws + WS_P); bf16_t* Y = (bf16_t*)(p.ws + WS_Y);
#pragma unroll 2
    for (int i = 0; i < 16; ++i) { const int chunk = tid + 512 * i, t = chunk >> 5, c8 = (chunk & 31) * 8; const size_t row = (size_t)(base_row + tok0 + t);
        const u32x4 hh = *(LAS u32x4*)(Hs + t * 256 + c8), zz = *(const u32x4*)(P + row * NPC + 5120 + 256 * cg4 + c8);
        u32x4 o;
        { const float z0 = bflo(zz.x), z1 = bfhi(zz.x); o.x = pk2(bflo(hh.x) * z0 * sigm(z0), bfhi(hh.x) * z1 * sigm(z1)); }
        { const float z0 = bflo(zz.y), z1 = bfhi(zz.y); o.y = pk2(bflo(hh.y) * z0 * sigm(z0), bfhi(hh.y) * z1 * sigm(z1)); }
        { const float z0 = bflo(zz.z), z1 = bfhi(zz.z); o.z = pk2(bflo(hh.z) * z0 * sigm(z0), bfhi(hh.z) * z1 * sigm(z1)); }
        { const float z0 = bflo(zz.w), z1 = bfhi(zz.w); o.w = pk2(bflo(hh.w) * z0 * sigm(z0), bfhi(hh.w) * z1 * sigm(z1)); }
        *(u32x4*)(Y + row * 2048 + 1024 + 256 * cg4 + c8) = o; }
    __syncthreads();
}

__device__ unsigned g_q[32 * 64];
DI int next_chunk(LAS unsigned char* lds, int qi, unsigned n) { asm volatile("" : "+s"(qi)); LAS int* slot = (LAS int*)(lds + LDS_BYTES - 64); if (ltid() == 0) *slot = (int)__hip_atomic_fetch_add(&g_q[qi * 64], n, __ATOMIC_RELAXED, __HIP_MEMORY_SCOPE_AGENT); __syncthreads(); return *slot; }
DI int next_task(LAS unsigned char* lds, int ph) { asm volatile("" : "+s"(ph)); LAS int* slot = (LAS int*)(lds + LDS_BYTES - 64); if (ltid() == 0) *slot = (int)gridDim.x + (int)__hip_atomic_fetch_add(&g_q[ph * 64], 1u, __ATOMIC_RELAXED, __HIP_MEMORY_SCOPE_AGENT); __syncthreads(); return *slot; }
#define XB_XCNT(j) (64 * (j))
#define XB_XSUB(j) (1024 + 64 * (j))
#define XB_XGEN(j) (2048 + 64 * (j))
#define XB_TOP 3072
#define XB_TOPGEN 3136
__device__ unsigned g_bar[3200];
DI unsigned xb_ld(unsigned* p) { return __hip_atomic_load(p, __ATOMIC_RELAXED, __HIP_MEMORY_SCOPE_AGENT); }
DI unsigned xb_add(unsigned* p, unsigned v) { return __hip_atomic_fetch_add(p, v, __ATOMIC_RELAXED, __HIP_MEMORY_SCOPE_AGENT); }
DI void xb_st(unsigned* p, unsigned v) { __hip_atomic_store(p, v, __ATOMIC_RELAXED, __HIP_MEMORY_SCOPE_AGENT); }
DI unsigned xb_xcc_id() { return (unsigned)__builtin_amdgcn_s_getreg((3 << 11) | 20) & 0xFu; }
#define XB_SPIN(cond) do { unsigned _sp = 0; while (cond) { __builtin_amdgcn_s_sleep(1); if (++_sp > (1u << 22)) break; } } while (0)
DI void grid_barrier_post() { if (ltid() == 0) { int z = 0; asm volatile("" : "+s"(z)); (void)xb_add(&g_bar[z + XB_XCNT(xb_xcc_id())], 1u); } }
DI void grid_barrier_clear_census() { if (lbid() == 0 && ltid() < 16) { int z = 0; asm volatile("" : "+s"(z)); xb_st(&g_bar[z + XB_XCNT(ltid())], 0u); } }
DI void grid_barrier(LAS unsigned char* lds) {
    asm volatile("s_waitcnt vmcnt(0)" ::: "memory");
    __syncthreads();
    if (ltid() == 0) {
        int z = 0; asm volatile("" : "+s"(z)); unsigned* bar = &g_bar[z];
        volatile LAS unsigned* st = (volatile LAS unsigned*)(lds + LDS_BYTES - 32);
        const unsigned x = xb_xcc_id(), G = gridDim.x;
        unsigned nloc = st[0], nx = st[1];
        if (nloc == 0u) {
            unsigned sum, cnt, mine, sp = 0u;
            for (;;) { sum = 0u; cnt = 0u; mine = 0u;
#pragma unroll
                for (unsigned j = 0; j < 16; ++j) { const unsigned c = xb_ld(&bar[XB_XCNT(j)]); sum += c; cnt += (c > 0u) ? 1u : 0u; mine = (j == x) ? c : mine; }
                if (sum == G) break;
                __builtin_amdgcn_s_sleep(1); if (++sp > (1u << 22)) break; }
            nloc = mine > 0u ? mine : 1u; nx = cnt > 0u ? cnt : 1u; st[0] = nloc; st[1] = nx; }
        const unsigned genx = xb_ld(&bar[XB_XGEN(x)]);
        const unsigned old = xb_add(&bar[XB_XSUB(x)], 1u);
        if (old + 1u == nloc) {
            xb_st(&bar[XB_XSUB(x)], 0u);
            __builtin_amdgcn_fence(__ATOMIC_RELEASE, "agent");
            asm volatile("s_waitcnt vmcnt(0)" ::: "memory");
            const unsigned gent = xb_ld(&bar[XB_TOPGEN]);
            const unsigned o2 = xb_add(&bar[XB_TOP], 1u);
            if (o2 + 1u == nx) { xb_st(&bar[XB_TOP], 0u); __builtin_amdgcn_fence(__ATOMIC_RELEASE, "agent"); asm volatile("s_waitcnt vmcnt(0)" ::: "memory"); xb_add(&bar[XB_TOPGEN], 1u); }
            else XB_SPIN(xb_ld(&bar[XB_TOPGEN]) == gent);
            __builtin_amdgcn_fence(__ATOMIC_ACQUIRE, "agent");
            xb_add(&bar[XB_XGEN(x)], 1u);
            asm volatile("s_waitcnt vmcnt(0)" ::: "memory");
        } else {
            XB_SPIN(xb_ld(&bar[XB_XGEN(x)]) == genx);
            __builtin_amdgcn_fence(__ATOMIC_ACQUIRE, "agent");
            asm volatile("s_waitcnt vmcnt(0)" ::: "memory");
        }
    }
    __syncthreads();
}

__global__ void __launch_bounds__(512) fwd_kernel(Params pp) {
    extern __shared__ __attribute__((aligned(16))) unsigned char lds_raw[];
    LAS unsigned char* lds = (LAS unsigned char*)lds_raw;
    if (pp.ph_hi > 1000) { cg::grid_group grid = cg::this_grid(); grid.sync(); }
    if (ltid() < 2) ((volatile LAS unsigned*)(lds + LDS_BYTES - 32))[ltid()] = 0u;
    __syncthreads();
    grid_barrier_post();
#pragma unroll 1
    for (int ph = pp.ph_lo; ph < pp.ph_hi; ++ph) {
        Params p = pp; { size_t zoff = 0; asm volatile("" : "+s"(zoff)); p.ws = pp.ws + zoff; }
        if (ph == 0) { if (lbid() == 0 && ltid() < 32) __hip_atomic_store(&g_q[ltid() * 64], 0u, __ATOMIC_RELAXED, __HIP_MEMORY_SCOPE_AGENT); for (int rep = 0; rep < REP_PREP; ++rep) phase_prep(lds, p); }
        else if (ph == NPHASE - 1) phase_final(p);
        else {
            int l = (ph - 1) / 6; const int sub = (ph - 1) % 6; asm volatile("" : "+s"(l));
            if (sub == 0) { for (int rep = 0; rep < REP_N; ++rep) phase_norm(p, l); }
            else if (sub == 1) {
                pg8::Gemm g{(const pg8::bf16_t*)(p.ws + WS_HX), (const pg8::bf16_t*)(p.ws + WS_WIN) + (size_t)l * NG1 * 2048, NTOK, NG1, 2048, 2048};
                pg8::StaticOrder S; S.init(NTOK, NG1, (int)gridDim.x, lbid());
                EpiIn E{(bf16_t*)(p.ws + WS_P), (float*)(p.ws + WS_GT)};
                for (int rep = 0; rep < REP_G1; ++rep) pg8::gemm_phase<EpiIn, pg8::StaticOrder>(lds, g, S, E);
                if (l < DEPTH - 1) {
                    __syncthreads();
                    for (int u = next_chunk(lds, 26 + l, 1u); u < T_WCONV; u = next_chunk(lds, 26 + l, 1u)) wconv_task(lds, p, l + 1, u);
                }
            } else if (sub == 2) {
                for (int t = lbid(); t < 272 + 480 + 128; t = next_task(lds, ph)) {
                    if (t < 272) { for (int rep = 0; rep < REP_M1; ++rep) m1_task(lds, p, l, t); }
                    else if (t < 752) { for (int rep = 0; rep < REP_R0; ++rep) r_task(lds, p, l, t - 272, 0); }
                    else { const int i = t - 752; if (i & 1) r_task(lds, p, l, 480 + (i >> 1), 0, 1, 2); else r_task(lds, p, l, 480 + (i >> 1), 0, 0, 1); } }
            } else if (sub == 3) { for (int rep = 0; rep < REP_M2; ++rep) phase_m2(p); }
            else if (sub == 4) {
                for (int t = lbid(); t < 544 + 136; t = next_task(lds, ph)) { if (t >= 136) { for (int rep = 0; rep < REP_M3; ++rep) m3_task(lds, p, l, t - 136); } else { for (int rep = 0; rep < REP_R1; ++rep) rs_task(lds, p, l, t); } }
            } else {
                const int M = 8192;
                pg8::Gemm g{(const pg8::bf16_t*)(p.ws + WS_Y), (const pg8::bf16_t*)(p.ws + WS_WOUT) + (size_t)l * 2048 * 2048, M, 2048, 2048, 2048};
                pg8::StaticOrder S; S.init(M, 2048, (int)gridDim.x, lbid());
                EpiOut E{p, l};
                pg8::gemm_phase<EpiOut, pg8::StaticOrder>(lds, g, S, E);
                if (l < DEPTH - 1) { const int sid = (int)gridDim.x - 1 - lbid();
                    if (sid < 128) { const int kpart = sid & 7, unit = sid >> 3;
                        pg8::Gemm g2{(const pg8::bf16_t*)(p.ws + WS_Y) + kpart * 256, (const pg8::bf16_t*)(p.ws + WS_WOUT) + (size_t)l * 2048 * 2048 + kpart * 256, NTOK, 2048, 256, 2048};
                        OneUnit S2{32 + (unit >> 3), unit & 7};
                        EpiPart E2{(float*)(p.ws + WS_PART) + (size_t)kpart * 512 * 2048};
                        __syncthreads();
                        pg8::gemm_phase<EpiPart, OneUnit>(lds, g2, S2, E2); } }
            }
        }
        __syncthreads();
        if (ph + 1 < pp.ph_hi) { grid_barrier(lds); if (ph == pp.ph_lo + 1) grid_barrier_clear_census(); }
    }
}

#else
#define LDSDECL extern __shared__ __attribute__((aligned(16))) unsigned char lds_raw[]; LAS unsigned char* lds = (LAS unsigned char*)lds_raw;
__global__ void __launch_bounds__(512) k_prep(Params p) { LDSDECL phase_prep(lds, p); }
__global__ void __launch_bounds__(512) k_norm(Params p) { phase_norm(p, p.ph_lo); }
__global__ void __launch_bounds__(512) k_final(Params p) { phase_final(p); }
__global__ void __launch_bounds__(512) k_g1(Params p) { LDSDECL int l = p.ph_lo;
  pg8::Gemm g{(const pg8::bf16_t*)(p.ws + WS_HX), (const pg8::bf16_t*)(p.ws + WS_WIN) + (size_t)l * NG1 * 2048, NTOK, NG1, 2048, 2048};
  pg8::StaticOrder S; S.init(NTOK, NG1, (int)gridDim.x, lbid()); EpiIn E{(bf16_t*)(p.ws + WS_P), (float*)(p.ws + WS_GT)};
  pg8::gemm_phase<EpiIn, pg8::StaticOrder>(lds, g, S, E); }
__global__ void __launch_bounds__(512) k_g2(Params p) { LDSDECL int l = p.ph_lo; const int M = (l == DEPTH - 1) ? 8192 : NTOK;
  pg8::Gemm g{(const pg8::bf16_t*)(p.ws + WS_Y), (const pg8::bf16_t*)(p.ws + WS_WOUT) + (size_t)l * 2048 * 2048, M, 2048, 2048, 2048};
  pg8::StaticOrder S; S.init(M, 2048, (int)gridDim.x, lbid()); EpiOut E{p, l};
  pg8::gemm_phase<EpiOut, pg8::StaticOrder>(lds, g, S, E); }
__global__ void __launch_bounds__(512) k_m1(Params p) { LDSDECL for (int t = lbid(); t < 272; t += gridDim.x) m1_task(lds, p, p.ph_lo, t); }
__global__ void __launch_bounds__(512) k_m2(Params p) { phase_m2(p); }
__global__ void __launch_bounds__(512) k_m3(Params p) { LDSDECL for (int t = lbid(); t < 544; t += gridDim.x) m3_task(lds, p, p.ph_lo, t); }
__global__ void __launch_bounds__(512) k_r0(Params p) { LDSDECL for (int t = lbid(); t < 544; t += gridDim.x) r_task(lds, p, p.ph_lo, t, 0); }
__global__ void __launch_bounds__(512) k_r1(Params p) { LDSDECL for (int t = lbid(); t < 544; t += gridDim.x) r_task(lds, p, p.ph_lo, t, 1); }
#endif


#ifdef PROBE
__global__ void __launch_bounds__(512) k_dump(Params p, size_t off, int isbf, size_t nelem) {
    for (size_t i = (size_t)lbid() * 512 + ltid(); i < (size_t)8192 * 2048; i += (size_t)gridDim.x * 512) {
        const size_t j = i % nelem; p.out[i] = isbf ? bf2f(((const bf16_t*)(p.ws + off))[j]) : ((const float*)(p.ws + off))[j]; }
}
#endif

extern "C" void kernel_launch(void* const* d_in, const int* in_sizes, int n_in, void* d_out, int out_size, void* d_ws, size_t ws_size, hipStream_t stream) {
    static int grid = 0;
    if (grid == 0) {
        int dev = 0, cus = 0, per_cu = 0;
        hipGetDevice(&dev); hipDeviceGetAttribute(&cus, hipDeviceAttributeMultiprocessorCount, dev);
#if SINGLE_LAUNCH
        if (hipFuncSetAttribute((const void*)fwd_kernel, hipFuncAttributeMaxDynamicSharedMemorySize, LDS_BYTES) != hipSuccess) { fprintf(stderr, "hipFuncSetAttribute failed\n"); grid = -1; return; }
        if (hipOccupancyMaxActiveBlocksPerMultiprocessor(&per_cu, (const void*)fwd_kernel, 512, LDS_BYTES) != hipSuccess || per_cu < 1) { fprintf(stderr, "occupancy query: %d\n", per_cu); per_cu = 1; }
#else
        { const void* ks[] = {(const void*)k_prep, (const void*)k_g1, (const void*)k_g2, (const void*)k_m1, (const void*)k_m3, (const void*)k_r0, (const void*)k_r1};
          for (int i = 0; i < 7; ++i) if (hipFuncSetAttribute(ks[i], hipFuncAttributeMaxDynamicSharedMemorySize, LDS_BYTES) != hipSuccess) { fprintf(stderr, "hipFuncSetAttribute failed\n"); grid = -1; return; } }
        per_cu = 1;
#endif
        (void)hipGetLastError();
        grid = cus * 1;
        if (ws_size < WS_END) { fprintf(stderr, "workspace too small\n"); grid = -1; return; }
    }
    if (grid < 0) return;
    Params p{};
    p.x = (const float*)d_in[0]; p.c = (const float*)d_in[1]; p.ctx = (const float*)d_in[2]; p.c_ctx = (const float*)d_in[3]; p.w_mod = (const float*)d_in[4]; p.b_mod = (const float*)d_in[5];
    p.norm_g = (const float*)d_in[6]; p.w_in = (const float*)d_in[7]; p.b_gate = (const float*)d_in[8]; p.cqw = (const float*)d_in[9]; p.cqb = (const float*)d_in[10]; p.mng = (const float*)d_in[11];
    p.crw = (const float*)d_in[12]; p.crb = (const float*)d_in[13]; p.w_rg = (const float*)d_in[14]; p.b_rg = (const float*)d_in[15]; p.lam = (const float*)d_in[16]; p.w_out = (const float*)d_in[17];
    p.final_g = (const float*)d_in[18]; p.out = (float*)d_out; p.ws = (unsigned char*)d_ws;
#if SINGLE_LAUNCH
    p.ph_lo = 0; p.ph_hi = NPHASE;
    void* args[] = {&p};
    hipError_t e = hipLaunchCooperativeKernel((const void*)fwd_kernel, dim3(grid), dim3(512), args, LDS_BYTES, stream);
    if (e != hipSuccess) fprintf(stderr, "cooperative launch failed: %s (grid %d)\n", hipGetErrorString(e), grid);
#else
    p.ph_lo = 0; p.ph_hi = 0;
    hipLaunchKernelGGL(k_prep, dim3(grid), dim3(512), LDS_BYTES, stream, p);
    for (int l = 0; l < DEPTH; ++l) { p.ph_lo = l;
        hipLaunchKernelGGL(k_norm, dim3(grid), dim3(512), 0, stream, p);
#if defined(PROBE) && PROBE == 0
        hipLaunchKernelGGL(k_dump, dim3(grid), dim3(512), 0, stream, p, WS_HX, 1, (size_t)NTOK * 2048); return;
#endif
        hipLaunchKernelGGL(k_g1, dim3(grid), dim3(512), LDS_BYTES, stream, p);
#if defined(PROBE) && PROBE == 1
        hipLaunchKernelGGL(k_dump, dim3(grid), dim3(512), 0, stream, p, WS_P + (size_t)1024 * NPC * 2, 1, (size_t)8192 * 2048); return;
#endif
        hipLaunchKernelGGL(k_m1, dim3(grid), dim3(512), LDS_BYTES, stream, p);
        hipLaunchKernelGGL(k_r0, dim3(grid), dim3(512), LDS_BYTES, stream, p);
        hipLaunchKernelGGL(k_m2, dim3(grid), dim3(512), 0, stream, p);
#if defined(PROBE) && PROBE == 2
        hipLaunchKernelGGL(k_dump, dim3(grid), dim3(512), 0, stream, p, WS_CIN, 1, (size_t)272 * 32768); return;
#endif
        hipLaunchKernelGGL(k_m3, dim3(grid), dim3(512), LDS_BYTES, stream, p);
        hipLaunchKernelGGL(k_r1, dim3(grid), dim3(512), LDS_BYTES, stream, p);
#if defined(PROBE) && PROBE == 3
        hipLaunchKernelGGL(k_dump, dim3(grid), dim3(512), 0, stream, p, WS_Y, 1, (size_t)8192 * 2048); return;
#endif
        hipLaunchKernelGGL(k_g2, dim3(grid), dim3(512), LDS_BYTES, stream, p); }
    hipLaunchKernelGGL(k_final, dim3(grid), dim3(512), 0, stream, p);
#endif
}
```

```cpp
#include <hip/hip_runtime.h>
#include <hip/hip_cooperative_groups.h>
#include <cstdio>
namespace cg = cooperative_groups;
__device__ __forceinline__ int ltid() { int t = threadIdx.x; asm volatile("" : "+v"(t)); return t; }
__device__ __forceinline__ int lbid() { int b = blockIdx.x; asm volatile("" : "+s"(b)); return b; }
namespace pg8 {
#define PG8_LAS __attribute__((address_space(3)))
typedef unsigned short bf16_t;
typedef short bf16x8 __attribute__((ext_vector_type(8)));
typedef float f32x4 __attribute__((ext_vector_type(4)));
typedef unsigned u32x4 __attribute__((ext_vector_type(4)));
constexpr int BM = 256, BK = 64, HALF = 128, HTB = HALF * BK * 2  , STAGE_BYTES = 8 * HTB, NXCD = 8, WGM = 8;

__host__ __device__ __forceinline__ int lds_byte(int r, int c) { const int st = (r >> 4) * 2 + (c >> 5), rr = r & 15, cc = c & 31, ob = rr * 64 + cc * 2; return st * 1024 + (ob ^ (((ob >> 9) & 1) << 5)); }
__host__ __device__ __forceinline__ void stage_rc(int b, int& R, int& C) { const int st = b / 1024, sb = b % 1024, swz = sb ^ (((sb >> 9) & 1) << 5); R = (st >> 1) * 16 + swz / 64; C = (st & 1) * 32 + (swz % 64) / 2; }
__host__ __device__ __forceinline__ int perm32(int rho) { const int n = rho >> 4, i = rho & 15; return 8 * (i >> 2) + 4 * n + (i & 3); }

struct Unit { int pm, pn; };
struct Gemm { const bf16_t* A; const bf16_t* Bt; int M, N, K, ld; };

struct StaticOrder {
    int nM, nN, nwg, G, c;
    __host__ __device__ void init(int M, int N, int G_, int c_) { nM = M / BM; nN = N / BM; nwg = nM * nN; G = G_; c = c_; }
    __host__ __device__ bool next(int i, Unit& u) const {
        const long L = (long)i * G + c; if (L >= nwg) return false;
        int wgid = (int)L; { const int q = nwg / NXCD, r = nwg % NXCD, xcd = wgid % NXCD, off = wgid / NXCD; wgid = (xcd < r ? xcd * (q + 1) : r * (q + 1) + (xcd - r) * q) + off; }
        const int nig = WGM * nN, gid = wgid / nig, fm = gid * WGM, gsz = (nM - fm) < WGM ? (nM - fm) : WGM;
        u.pm = fm + ((wgid % nig) % gsz); u.pn = (wgid % nig) / gsz; return true;
    }
    __device__ __forceinline__ void a_ready(const Unit&) const {}
    __device__ __forceinline__ void done(const Unit&) const {}
};
__device__ __forceinline__ unsigned cvt_pk_bf16(float lo, float hi) { unsigned r; asm volatile("v_cvt_pk_bf16_f32 %0, %1, %2" : "=v"(r) : "v"(lo), "v"(hi)); return r; }
template <class Epi, class Sched>
__device__ __forceinline__ void gemm_phase(PG8_LAS unsigned char* lds, const Gemm g, const Sched& S, const Epi& E) {
    const int tid = ltid(), wid = __builtin_amdgcn_readfirstlane(tid >> 6), lane = tid & 63, wr = wid >> 2, wc = wid & 3, fr = lane & 15, fq = lane >> 4;
    const int K = g.K, nt = K / BK;
    unsigned voffA[2], voffB[2];
#pragma unroll
    for (int i = 0; i < 2; ++i) { int R, C; stage_rc(tid * 16 + i * 8192, R, C); const int Rb = Epi::PERM ? ((R & ~31) + perm32(R & 31)) : R;
        voffA[i] = (unsigned)(R * g.ld + C) * 2u; voffB[i] = (unsigned)(Rb * g.ld + C) * 2u; }
    const size_t kstep = (size_t)(BK * 2);
    const size_t hstep = (size_t)HALF * g.ld * 2;
    const size_t tstep = 2 * hstep;
    const unsigned ldsw = (unsigned)wid * 1024u;
    const int aoff = lds_byte(wr * 64 + fr, fq * 8), boff = lds_byte(wc * 32 + fr, fq * 8);
#define PG8_SA(b, h) (((b) * 2 + (h)) * HTB)
#define PG8_SB(b, h) ((4 + (b) * 2 + (h)) * HTB)
#define PG8_STAGE(bufoff, gbase, voff) do { _Pragma("unroll") for (int _i = 0; _i < 2; ++_i) \
        __builtin_amdgcn_global_load_lds((const unsigned*)((const char*)(gbase) + (voff)[_i]), (PG8_LAS unsigned*)(lds + (bufoff) + ldsw + _i * 8192), 16, 0, 0); } while (0)
#define PG8_LDA(dst, b, h) do { _Pragma("unroll") for (int m = 0; m < 4; ++m) _Pragma("unroll") for (int k = 0; k < 2; ++k) dst[m][k] = *(const PG8_LAS bf16x8*)(lds + PG8_SA(b, h) + aoff + m * 2048 + k * 1024); } while (0)
#define PG8_LDB(dst, b, h) do { _Pragma("unroll") for (int n = 0; n < 2; ++n) _Pragma("unroll") for (int k = 0; k < 2; ++k) dst[n][k] = *(const PG8_LAS bf16x8*)(lds + PG8_SB(b, h) + boff + n * 2048 + k * 1024); } while (0)
#define PG8_MMA(ai, bj, At, Bt) do { __builtin_amdgcn_s_setprio(1); _Pragma("unroll") for (int m = 0; m < 4; ++m) _Pragma("unroll") for (int n = 0; n < 2; ++n) _Pragma("unroll") for (int k = 0; k < 2; ++k) \
        acc[ai][bj][m][n] = __builtin_amdgcn_mfma_f32_16x16x32_bf16(Bt[n][k], At[m][k], acc[ai][bj][m][n], 0, 0, 0); __builtin_amdgcn_s_setprio(0); } while (0)
#define PG8_WAIT_V(n) asm volatile("s_waitcnt vmcnt(" #n ")" ::: "memory")
#define PG8_WAIT_L(n) asm volatile("s_waitcnt lgkmcnt(" #n ")" ::: "memory")
#define PG8_BAR __builtin_amdgcn_s_barrier()
#define PG8_SCHED __builtin_amdgcn_sched_barrier(0)
    Unit cur, nxt; int ui = 0;
    if (!S.next(0, cur)) return;
    f32x4 acc[2][2][4][2];
#pragma unroll
    for (int a = 0; a < 2; ++a)
#pragma unroll
        for (int b = 0; b < 2; ++b)
#pragma unroll
            for (int m = 0; m < 4; ++m)
#pragma unroll
                for (int n = 0; n < 2; ++n) acc[a][b][m][n] = (f32x4){0.f, 0.f, 0.f, 0.f};
    bf16x8 At[4][2], B0[2][2], B1[2][2];
    const char* cA = (const char*)g.A + (size_t)cur.pm * tstep; const char* cB = (const char*)g.Bt + (size_t)cur.pn * tstep;
    S.a_ready(cur);
    PG8_STAGE(PG8_SB(0, 0), cB, voffB); PG8_STAGE(PG8_SA(0, 0), cA, voffA); PG8_STAGE(PG8_SB(0, 1), cB + hstep, voffB); PG8_STAGE(PG8_SA(0, 1), cA + hstep, voffA);
    if (wr == 1) PG8_BAR;
    PG8_WAIT_V(4); PG8_BAR;
    PG8_STAGE(PG8_SB(1, 0), cB + kstep, voffB); PG8_STAGE(PG8_SA(1, 0), cA + kstep, voffA); PG8_STAGE(PG8_SB(1, 1), cB + hstep + kstep, voffB);
    PG8_WAIT_V(6); PG8_BAR;
    for (;;) {
        const bool has_next = S.next(ui + 1, nxt);
        const char* nA = has_next ? (const char*)g.A + (size_t)nxt.pm * tstep : cA; const char* nB = has_next ? (const char*)g.Bt + (size_t)nxt.pn * tstep : cB;
        for (int t = 0; t < nt; t += 2) {
            const bool last = (t == nt - 2);
            const char* a1 = cA + (size_t)(t + 1) * kstep;
            const char* a2 = last ? nA : cA + (size_t)(t + 2) * kstep; const char* b2 = last ? nB : cB + (size_t)(t + 2) * kstep;
            const char* a3 = a2 + kstep; const char* b3 = b2 + kstep;
            if (last && has_next) S.a_ready(nxt);
            PG8_LDB(B0, 0, 0); PG8_SCHED; PG8_LDA(At, 0, 0); PG8_STAGE(PG8_SA(1, 1), a1 + hstep, voffA);
            PG8_WAIT_L(8); PG8_BAR; PG8_WAIT_L(0); PG8_MMA(0, 0, At, B0); PG8_BAR; PG8_SCHED;
            PG8_LDB(B1, 0, 1); PG8_STAGE(PG8_SB(0, 0), b2, voffB);
            PG8_BAR; PG8_WAIT_L(0); PG8_MMA(0, 1, At, B1); PG8_BAR;
            PG8_LDA(At, 0, 1); PG8_STAGE(PG8_SA(0, 0), a2, voffA);
            PG8_BAR; PG8_WAIT_L(0); PG8_MMA(1, 0, At, B0); PG8_BAR; PG8_SCHED;
            PG8_STAGE(PG8_SB(0, 1), b2 + hstep, voffB);
            PG8_WAIT_V(6); PG8_BAR; PG8_MMA(1, 1, At, B1); PG8_BAR;
            PG8_LDB(B0, 1, 0); PG8_SCHED; PG8_LDA(At, 1, 0); PG8_STAGE(PG8_SA(0, 1), a2 + hstep, voffA);
            PG8_WAIT_L(8); PG8_BAR; PG8_WAIT_L(0); PG8_MMA(0, 0, At, B0); PG8_BAR; PG8_SCHED;
            PG8_LDB(B1, 1, 1); PG8_STAGE(PG8_SB(1, 0), b3, voffB);
            PG8_BAR; PG8_WAIT_L(0); PG8_MMA(0, 1, At, B1); PG8_BAR;
            PG8_LDA(At, 1, 1); PG8_STAGE(PG8_SA(1, 0), a3, voffA);
            PG8_BAR; PG8_WAIT_L(0); PG8_MMA(1, 0, At, B0); PG8_BAR; PG8_SCHED;
            PG8_STAGE(PG8_SB(1, 1), b3 + hstep, voffB);
            PG8_WAIT_V(6); PG8_BAR; PG8_MMA(1, 1, At, B1); PG8_BAR;
        }
        if constexpr (!Epi::AFTER_DRAIN) { E(acc, cur, wr, wc, fr, fq); S.done(cur); }
        if (!has_next) break;
#pragma unroll
        for (int a = 0; a < 2; ++a)
#pragma unroll
            for (int b = 0; b < 2; ++b)
#pragma unroll
                for (int m = 0; m < 4; ++m)
#pragma unroll
                    for (int n = 0; n < 2; ++n) acc[a][b][m][n] = (f32x4){0.f, 0.f, 0.f, 0.f};
        cur = nxt; cA = nA; cB = nB; ++ui;
    }
    PG8_WAIT_V(0);
    if (wr == 0) PG8_BAR;
    PG8_BAR;
    if constexpr (Epi::AFTER_DRAIN) { E.fused(acc, cur, wr, wc, fr, fq, lds, wid, lane); S.done(cur); }
#undef PG8_SA
#undef PG8_SB
#undef PG8_STAGE
#undef PG8_LDA
#undef PG8_LDB
#undef PG8_MMA
#undef PG8_WAIT_V
#undef PG8_WAIT_L
#undef PG8_BAR
#undef PG8_SCHED
}
}

__device__ __forceinline__ float shx(float v, int m) {
    const int x = __float_as_int(v); int y;
    switch (m) {
        case 1: y = __builtin_amdgcn_ds_swizzle(x, (1 << 10) | 0x1f); break;
        case 2: y = __builtin_amdgcn_ds_swizzle(x, (2 << 10) | 0x1f); break;
        case 4: y = __builtin_amdgcn_ds_swizzle(x, (4 << 10) | 0x1f); break;
        case 8: y = __builtin_amdgcn_ds_swizzle(x, (8 << 10) | 0x1f); break;
        case 16: y = __builtin_amdgcn_ds_swizzle(x, (16 << 10) | 0x1f); break;
        default: return __shfl_xor(v, 32);
    }
    return __int_as_float(y);
}

#define DI __device__ __forceinline__
#define LAS __attribute__((address_space(3)))
typedef unsigned short bf16_t;
typedef short bf16x8 __attribute__((ext_vector_type(8)));
typedef float f32x4 __attribute__((ext_vector_type(4)));
typedef unsigned u32x4 __attribute__((ext_vector_type(4)));
typedef unsigned u32x2 __attribute__((ext_vector_type(2)));

#ifndef REP_M1
#define REP_M1 1
#endif
#ifndef REP_M3
#define REP_M3 1
#endif
#ifndef REP_R0
#define REP_R0 1
#endif
#ifndef REP_R1
#define REP_R1 1
#endif
#ifndef REP_M2
#define REP_M2 1
#endif
#ifndef REP_PREP
#define REP_PREP 1
#endif
#ifndef REP_G1
#define REP_G1 1
#endif
#ifndef REP_N
#define REP_N 1
#endif
#ifndef SINGLE_LAUNCH
#define SINGLE_LAUNCH 1
#endif
constexpr int NTOK = 8704, NPC = 6144, NG1 = 6400, DEPTH = 4, NPHASE = 26;
constexpr int LDS_BYTES = 147456;
constexpr size_t al256(size_t x) { return (x + 255) & ~(size_t)255; }
constexpr size_t WS_WIN = 0;
constexpr size_t WS_WOUT = WS_WIN + al256((size_t)4 * NG1 * 2048 * 2);
constexpr size_t WS_WRT = WS_WOUT + al256((size_t)4 * 2048 * 2048 * 2);
constexpr size_t WS_MOD = WS_WRT + al256((size_t)256 * 4096 * 2);
constexpr size_t MOD_BYTES = (size_t)4 * 3 * 6144 * 4;
constexpr size_t WS_HX = WS_MOD + al256(MOD_BYTES);
constexpr size_t WS_P = WS_HX + al256((size_t)NTOK * 2048 * 2);
constexpr size_t WS_GT = WS_P + al256((size_t)NTOK * NPC * 2);
constexpr size_t WS_XB = WS_GT + al256((size_t)NTOK * 16 * 4);
constexpr size_t WS_Y = WS_XB + al256((size_t)NTOK * 2048 * 4);
constexpr size_t WS_QC = WS_Y + al256((size_t)NTOK * 2048 * 2);
constexpr size_t WS_KC = WS_QC + al256((size_t)8 * 4352 * 128 * 2);
constexpr size_t WS_VT = WS_KC + al256((size_t)8 * 4352 * 128 * 2);
constexpr size_t WS_EG = WS_VT + al256((size_t)8 * 17 * 4 * 256 * 64 * 2);
constexpr size_t WS_BG = WS_EG + al256((size_t)16 * 4352 * 4);
constexpr size_t WS_JS = WS_BG + al256((size_t)16 * 4352 * 4);
constexpr size_t WS_DC = WS_JS + al256((size_t)272 * 2 * 4);
constexpr size_t WS_DN = WS_DC + al256((size_t)272 * 32768 * 4);
constexpr size_t WS_CIN = WS_DN + al256((size_t)272 * 128 * 4);
constexpr size_t WS_NIN = WS_CIN + al256((size_t)272 * 32768 * 2);
constexpr size_t WS_MIN = WS_NIN + al256((size_t)272 * 128 * 4);
constexpr size_t WS_RAGG = WS_MIN + al256((size_t)272 * 4);
constexpr size_t WS_LU = WS_RAGG + al256((size_t)34 * 2 * 1024 * 2 * 4);
constexpr size_t WS_PART = WS_LU + al256((size_t)2 * NTOK * 1024 * 4);
constexpr size_t WS_END = WS_PART + al256((size_t)8 * 512 * 2048 * 4);

struct Params {
    const float *x, *c, *ctx, *c_ctx, *w_mod, *b_mod, *norm_g, *w_in, *b_gate, *cqw, *cqb, *mng, *crw, *crb, *w_rg, *b_rg, *lam, *w_out, *final_g;
    float* out; unsigned char* ws; int ph_lo, ph_hi;
};

DI unsigned pk2(float lo, float hi) { unsigned r; asm("v_cvt_pk_bf16_f32 %0, %1, %2" : "=v"(r) : "v"(lo), "v"(hi)); return r; }
DI unsigned f2bf(float f) { return pk2(f, f) & 0xffffu; }
DI float bf2f(unsigned h) { return __uint_as_float(h << 16); }
DI float bflo(unsigned w) { return __uint_as_float(w << 16); }
DI float bfhi(unsigned w) { return __uint_as_float(w & 0xffff0000u); }
DI float sigm(float x) { return __builtin_amdgcn_rcpf(1.f + __expf(-x)); }
DI float one_m_expneg(float t, float a2) { const float pl = t * (1.f - t * 0.5f * (1.f - t * (1.f / 3.f) * (1.f - t * 0.25f * (1.f - t * 0.2f * (1.f - t * (1.f / 6.f) * (1.f - t * (1.f / 7.f))))))); return t < 0.25f ? pl : 1.f - a2; }
#define MFMA16(a, b, c) __builtin_amdgcn_mfma_f32_16x16x32_bf16((a), (b), (c), 0, 0, 0)
DI const float* xsrc(const Params& p, int l, int row) {
    if (l == 0) return row < 8192 ? p.x + (size_t)row * 2048 : p.ctx + (size_t)(row - 8192) * 2048;
    return (const float*)(p.ws + WS_XB) + (size_t)row * 2048;
}
DI int pos_row(int b, int pp) { if (pp < 256) return 8192 + b * 256 + pp; const int q = pp - 256; return b * 4096 + (q & 63) * 64 + (q >> 6); }

DI void tr_tile(LAS unsigned char* lds, const float* src, int ld_src, int k0, int n0, int ncols, bf16_t* dst, int ld_dst, int mode) {
    LAS bf16_t* T = (LAS bf16_t*)lds;
    const int tid = ltid(), kr = tid >> 4, nc = tid & 15;
    { const int n = n0 + 4 * nc; float4 v0 = make_float4(0.f, 0.f, 0.f, 0.f), v1 = v0;
      if (n < ncols) { v0 = *(const float4*)(src + (size_t)(k0 + 2 * kr) * ld_src + n); v1 = *(const float4*)(src + (size_t)(k0 + 2 * kr + 1) * ld_src + n); }
      LAS unsigned* T32 = (LAS unsigned*)lds;
      T32[(4 * nc + 0) * 36 + kr] = pk2(v0.x, v1.x); T32[(4 * nc + 1) * 36 + kr] = pk2(v0.y, v1.y);
      T32[(4 * nc + 2) * 36 + kr] = pk2(v0.z, v1.z); T32[(4 * nc + 3) * 36 + kr] = pk2(v0.w, v1.w); }
    __syncthreads();
    { const int n = tid >> 3, kc = tid & 7, sn = n0 + n;
      if (sn < ncols) { const int dr = mode == 1 ? (sn < 4096 ? sn : (sn < 4112 ? 6144 + sn - 4096 : sn - 16)) : sn;
          const u32x4 w = *(LAS u32x4*)(T + n * 72 + 8 * kc); *(u32x4*)(dst + (size_t)dr * ld_dst + k0 + 8 * kc) = w; } }
    __syncthreads();
}
DI void tr_tile4(LAS unsigned char* lds, const float* src, int ld_src, int k0, int n0, int ncols, bf16_t* dst, int ld_dst, int mode) {
    LAS unsigned* T32 = (LAS unsigned*)lds;
    const int tid = ltid(), kr = tid >> 4, nc = tid & 15;
    float4 v0[4], v1[4];
#pragma unroll
    for (int ti = 0; ti < 4; ++ti) { const int n = n0 + 64 * ti + 4 * nc; v0[ti] = make_float4(0.f, 0.f, 0.f, 0.f); v1[ti] = v0[ti];
        if (n < ncols) { v0[ti] = *(const float4*)(src + (size_t)(k0 + 2 * kr) * ld_src + n); v1[ti] = *(const float4*)(src + (size_t)(k0 + 2 * kr + 1) * ld_src + n); } }
#pragma unroll
    for (int ti = 0; ti < 4; ++ti) { LAS unsigned* T = T32 + ti * 2304;
        T[(4 * nc + 0) * 36 + kr] = pk2(v0[ti].x, v1[ti].x); T[(4 * nc + 1) * 36 + kr] = pk2(v0[ti].y, v1[ti].y);
        T[(4 * nc + 2) * 36 + kr] = pk2(v0[ti].z, v1[ti].z); T[(4 * nc + 3) * 36 + kr] = pk2(v0[ti].w, v1[ti].w); }
    __syncthreads();
    { const int n = tid >> 3, kc = tid & 7;
#pragma unroll
      for (int ti = 0; ti < 4; ++ti) { const int sn = n0 + 64 * ti + n;
          if (sn < ncols) { const int dr = mode == 1 ? (sn < 4096 ? sn : (sn < 4112 ? 6144 + sn - 4096 : sn - 16)) : sn;
              const u32x4 w = *(LAS u32x4*)((LAS bf16_t*)(T32 + ti * 2304) + n * 72 + 8 * kc); *(u32x4*)(dst + (size_t)dr * ld_dst + k0 + 8 * kc) = w; } } }
    __syncthreads();
}
DI void mod_task(LAS unsigned char* lds, const Params& p, int l, int cgp) {
    LAS float* red = (LAS float*)lds;
    const int tid = ltid(), kg = tid >> 4, cl = tid & 15, col = cgp * 64 + 4 * cl;
    const float* w = p.w_mod + ((size_t)l * 2048 + kg * 64) * 6144 + col;
    float4 a0 = make_float4(0.f, 0.f, 0.f, 0.f), a1 = a0, a2 = a0;
#pragma unroll 4
    for (int k = 0; k < 64; ++k) { const float4 v = *(const float4*)(w + (size_t)k * 6144); const int kk = kg * 64 + k;
        const float c0 = p.c[kk], c1 = p.c[2048 + kk], c2 = p.c_ctx[kk]; const float s0 = c0 * sigm(c0), s1 = c1 * sigm(c1), s2 = c2 * sigm(c2);
        a0.x += s0 * v.x; a0.y += s0 * v.y; a0.z += s0 * v.z; a0.w += s0 * v.w; a1.x += s1 * v.x; a1.y += s1 * v.y; a1.z += s1 * v.z; a1.w += s1 * v.w;
        a2.x += s2 * v.x; a2.y += s2 * v.y; a2.z += s2 * v.z; a2.w += s2 * v.w; }
    *(LAS f32x4*)(red + (kg * 3 + 0) * 64 + 4 * cl) = (f32x4){a0.x, a0.y, a0.z, a0.w}; *(LAS f32x4*)(red + (kg * 3 + 1) * 64 + 4 * cl) = (f32x4){a1.x, a1.y, a1.z, a1.w}; *(LAS f32x4*)(red + (kg * 3 + 2) * 64 + 4 * cl) = (f32x4){a2.x, a2.y, a2.z, a2.w};
    __syncthreads();
    if (tid < 192) { const int r = tid >> 6, c = tid & 63; float sum = 0.f;
#pragma unroll
        for (int g2 = 0; g2 < 32; ++g2) sum += red[(g2 * 3 + r) * 64 + c];
        const int col = cgp * 64 + c; const float v = sum + p.b_mod[(size_t)l * 6144 + col];
        ((float*)(p.ws + WS_MOD))[(size_t)l * 3 * 6144 + r * 6144 + col] = (col >= 2048 && col < 4096) ? (1.f + v) * p.norm_g[l * 2048 + col - 2048] : v; }
    __syncthreads();
}
DI void wconv_task(LAS unsigned char* lds, const Params& p, int l, int u) {
    if (u < 32 * 25) { const int kt = u / 25, ng = u % 25;
        tr_tile4(lds, p.w_in + (size_t)l * 2048 * 6160, 6160, kt * 64, ng * 256, 6160, (bf16_t*)(p.ws + WS_WIN) + (size_t)l * NG1 * 2048, 2048, 1); }
    else { const int r = u - 32 * 25, kt = r >> 3, ng = r & 7;
        tr_tile4(lds, p.w_out + (size_t)l * 2048 * 2048, 2048, kt * 64, ng * 256, 2048, (bf16_t*)(p.ws + WS_WOUT) + (size_t)l * 2048 * 2048, 2048, 0); }
}
constexpr int T_WCONV = 32 * 25 + 256;
DI void phase_prep(LAS unsigned char* lds, const Params& p) {
    constexpr int T_RG = 256, T_MOD = 4 * 96;
    for (int t = lbid(); t < T_MOD + T_WCONV + T_RG; t += gridDim.x) {
        if (t < T_MOD) { mod_task(lds, p, t / 96, t % 96); }
        else if (t < T_MOD + T_WCONV) wconv_task(lds, p, 0, t - T_MOD);
        else { const int m = t - T_MOD - T_WCONV; tr_tile(lds, p.w_rg + (size_t)m * 4096, 64, 0, 0, 64, (bf16_t*)(p.ws + WS_WRT) + (size_t)m * 4096, 64, 0); }
    }
}

DI float wave_sum(float v) { v += shx(v, 32); v += shx(v, 16); v += shx(v, 8); v += shx(v, 4); v += shx(v, 2); v += shx(v, 1); return v; }
DI void phase_norm(const Params& p, int l) {
    const int wid = ltid() >> 6, lane = ltid() & 63;
    const float* MOD = (const float*)(p.ws + WS_MOD) + (size_t)l * 3 * 6144; const float* bm = p.b_mod + (size_t)l * 6144; const float* g = p.norm_g + l * 2048;
    bf16_t* HX = (bf16_t*)(p.ws + WS_HX);
    const int G8 = (int)gridDim.x * 8, nlat = (8192 + G8 - 1) / G8, bid = lbid();
    for (int it = 0; ; ++it) { int row;
        if (it < nlat) { row = bid * 8 + wid + it * G8; if (row >= 8192) continue; }
        else { const int c = bid * 2 + wid + (it - nlat) * (int)gridDim.x * 2; if (wid >= 2 || c >= 512) break; row = 8192 + c; }
        const int rt = row < 8192 ? (row >> 12) : 2;
        float4 v[8]; float ss = 0.f;
        if (l > 0 && row >= 8192) {
            const float* xo = xsrc(p, l - 1, row); const float* PART = (const float*)(p.ws + WS_PART) + (size_t)(row - 8192) * 2048;
            const float* MODp = (const float*)(p.ws + WS_MOD) + (size_t)(l - 1) * 3 * 6144 + 2 * 6144 + 4096; const float* bmp = p.b_mod + (size_t)(l - 1) * 6144 + 4096;
            float* XBw = (float*)(p.ws + WS_XB) + (size_t)row * 2048;
#pragma unroll
            for (int i = 0; i < 8; ++i) { const int c = (i * 64 + lane) * 4; float4 a = *(const float4*)(PART + c);
#pragma unroll
                for (int k = 1; k < 8; ++k) { const float4 t2 = *(const float4*)(PART + (size_t)k * 512 * 2048 + c); a.x += t2.x; a.y += t2.y; a.z += t2.z; a.w += t2.w; }
                const float4 x0 = *(const float4*)(xo + c), g1 = *(const float4*)(MODp + c);
                v[i].x = x0.x + g1.x * a.x; v[i].y = x0.y + g1.y * a.y; v[i].z = x0.z + g1.z * a.z; v[i].w = x0.w + g1.w * a.w;
                *(float4*)(XBw + c) = v[i]; }
        } else { const float* xs = xsrc(p, l, row);
#pragma unroll
            for (int i = 0; i < 8; ++i) v[i] = *(const float4*)(xs + (i * 64 + lane) * 4); }
#pragma unroll
        for (int i = 0; i < 8; ++i) ss += v[i].x * v[i].x + v[i].y * v[i].y + v[i].z * v[i].z + v[i].w * v[i].w;
        ss = wave_sum(ss);
        const float rstd = rsqrtf(ss * (1.f / 2048.f) + 1e-6f);
#pragma unroll
        for (int i = 0; i < 8; ++i) { const int c = (i * 64 + lane) * 4;
            const float4 sh = *(const float4*)(MOD + rt * 6144 + c), sc = *(const float4*)(MOD + rt * 6144 + 2048 + c);
            const float y0 = v[i].x * rstd * sc.x + sh.x, y1 = v[i].y * rstd * sc.y + sh.y;
            const float y2 = v[i].z * rstd * sc.z + sh.z, y3 = v[i].w * rstd * sc.w + sh.w;
            u32x2 w; w.x = pk2(y0, y1); w.y = pk2(y2, y3); *(u32x2*)(HX + (size_t)row * 2048 + c) = w; }
    }
}
DI void phase_final(const Params& p) {
    const int wid = ltid() >> 6, lane = ltid() & 63;
    const float* XB = (const float*)(p.ws + WS_XB);
    for (int row = lbid() * 8 + wid; row < 8192; row += gridDim.x * 8) {
        const float* xs = XB + (size_t)row * 2048; float4 v[8]; float ss = 0.f;
#pragma unroll
        for (int i = 0; i < 8; ++i) { v[i] = *(const float4*)(xs + (i * 64 + lane) * 4); ss += v[i].x * v[i].x + v[i].y * v[i].y + v[i].z * v[i].z + v[i].w * v[i].w; }
        ss = wave_sum(ss);
        const float rstd = rsqrtf(ss * (1.f / 2048.f) + 1e-6f);
#pragma unroll
        for (int i = 0; i < 8; ++i) { const int c = (i * 64 + lane) * 4; const float4 gg = *(const float4*)(p.final_g + c);
            float4 o; o.x = v[i].x * rstd * gg.x; o.y = v[i].y * rstd * gg.y; o.z = v[i].z * rstd * gg.z; o.w = v[i].w * rstd * gg.w; *(float4*)(p.out + (size_t)row * 2048 + c) = o; }
    }
}

struct EpiIn {
    static constexpr bool PERM = true, AFTER_DRAIN = false;
    bf16_t* P; float* GT;
    DI void operator()(const f32x4 (&acc)[2][2][4][2], const pg8::Unit& u, int wr, int wc, int fr, int fq) const {
        const int row0 = u.pm * 256 + wr * 64 + fr;
        if (u.pn < 24) { const int col0 = u.pn * 256 + wc * 32 + 8 * fq;
#pragma unroll
            for (int ai = 0; ai < 2; ++ai)
#pragma unroll
                for (int m = 0; m < 4; ++m) { bf16_t* rowp = P + (size_t)(row0 + ai * 128 + m * 16) * NPC + col0;
#pragma unroll
                    for (int bj = 0; bj < 2; ++bj) { const f32x4 v0 = acc[ai][bj][m][0], v1 = acc[ai][bj][m][1];
                        u32x4 w; w.x = pg8::cvt_pk_bf16(v0[0], v0[1]); w.y = pg8::cvt_pk_bf16(v0[2], v0[3]); w.z = pg8::cvt_pk_bf16(v1[0], v1[1]); w.w = pg8::cvt_pk_bf16(v1[2], v1[3]);
                        *(u32x4*)(rowp + bj * 128) = w; } }
        } else if (wc == 0 && fq < 2) {
#pragma unroll
            for (int ai = 0; ai < 2; ++ai)
#pragma unroll
                for (int m = 0; m < 4; ++m) { float* rp = GT + (size_t)(row0 + ai * 128 + m * 16) * 16 + 8 * fq; *(f32x4*)rp = acc[ai][0][m][0]; *(f32x4*)(rp + 4) = acc[ai][0][m][1]; }
        }
    }
};
struct EpiOut {
    static constexpr bool PERM = false, AFTER_DRAIN = false;
    Params p; int l;
    DI void operator()(const f32x4 (&acc)[2][2][4][2], const pg8::Unit& u, int wr, int wc, int fr, int fq) const {
        const int row0 = u.pm * 256 + wr * 64 + fr, col0 = u.pn * 256 + wc * 32 + 4 * fq, rt = u.pm < 32 ? (u.pm >> 4) : 2;
        const float* MOD = (const float*)(p.ws + WS_MOD) + (size_t)l * 3 * 6144 + rt * 6144 + 4096; const float* bm = p.b_mod + (size_t)l * 6144 + 4096;
        f32x4 gt[2][2];
#pragma unroll
        for (int bj = 0; bj < 2; ++bj)
#pragma unroll
            for (int n = 0; n < 2; ++n) gt[bj][n] = *(const f32x4*)(MOD + col0 + bj * 128 + n * 16);
        float* XB = (float*)(p.ws + WS_XB);
#pragma unroll
        for (int ai = 0; ai < 2; ++ai)
#pragma unroll
            for (int m = 0; m < 4; ++m) { const int r = row0 + ai * 128 + m * 16; const float* xs = xsrc(p, l, r) + col0; float* xo = XB + (size_t)r * 2048 + col0;
#pragma unroll
                for (int bj = 0; bj < 2; ++bj)
#pragma unroll
                    for (int n = 0; n < 2; ++n) { const f32x4 o = *(const f32x4*)(xs + bj * 128 + n * 16) + gt[bj][n] * acc[ai][bj][m][n]; *(f32x4*)(xo + bj * 128 + n * 16) = o; } }
    }
};

struct OneUnit { int pm, pn;
    DI bool next(int i, pg8::Unit& u) const { if (i) return false; u.pm = pm; u.pn = pn; return true; }
    DI void a_ready(const pg8::Unit&) const {}
    DI void done(const pg8::Unit&) const {} };
struct EpiPart {
    static constexpr bool PERM = false, AFTER_DRAIN = false;
    float* part;
    DI void operator()(const f32x4 (&acc)[2][2][4][2], const pg8::Unit& u, int wr, int wc, int fr, int fq) const {
        const int row0 = (u.pm - 32) * 256 + wr * 64 + fr, col0 = u.pn * 256 + wc * 32 + 4 * fq;
#pragma unroll
        for (int ai = 0; ai < 2; ++ai)
#pragma unroll
            for (int m = 0; m < 4; ++m) { float* xo = part + (size_t)(row0 + ai * 128 + m * 16) * 2048 + col0;
#pragma unroll
                for (int bj = 0; bj < 2; ++bj)
#pragma unroll
                    for (int n = 0; n < 2; ++n) *(f32x4*)(xo + bj * 128 + n * 16) = acc[ai][bj][m][n]; }
    }
};

DI void m1_task(LAS unsigned char* lds, const Params& p, int l, int task) {
    const int dir = task & 1, J = (task >> 1) % 17, bh = (task >> 1) / 17, b = bh >> 2, h = bh & 3;
    const int chain = bh * 2 + dir, sidx = chain * 17 + J;
    const int tid = ltid(), wid = tid >> 6, lane = tid & 63, r = lane & 15, q = lane >> 4;
    LAS bf16_t* Ktw = (LAS bf16_t*)lds;
    LAS bf16_t* Vts = (LAS bf16_t*)(lds + 18432);
    LAS float* wv = (LAS float*)(lds + 55296);
    LAS float* sc = (LAS float*)(lds + 56320);
    const bf16_t* P = (const bf16_t*)(p.ws + WS_P); const float* GT = (const float*)(p.ws + WS_GT);
    float* EG = (float*)(p.ws + WS_EG); float* BG = (float*)(p.ws + WS_BG); float* JS = (float*)(p.ws + WS_JS);
    float e_val = 0.f, bsum = 0.f; const int idx = dir ? 255 - tid : tid;
    if (tid < 256) {
        const int row = pos_row(b, J * 256 + idx);
        const float ig = GT[(size_t)row * 16 + dir * 8 + h] + p.b_gate[l * 16 + dir * 8 + h];
        const float fg = GT[(size_t)row * 16 + dir * 8 + 4 + h] + p.b_gate[l * 16 + dir * 8 + 4 + h];
        float s = fminf(fg, 0.f) - __logf(1.f + __expf(-fabsf(fg)));
#pragma unroll
        for (int o = 1; o < 64; o <<= 1) { const float t = __shfl_up(s, o); if (lane >= o) s += t; }
        if (lane == 63) sc[wid] = s;
        bsum = s; e_val = ig;
    }
    __syncthreads();
    if (tid < 256) { float off = 0.f; for (int w = 0; w < wid; ++w) off += sc[w]; bsum += off; e_val -= bsum;
        EG[(size_t)chain * 4352 + J * 256 + idx] = e_val; BG[(size_t)chain * 4352 + J * 256 + idx] = bsum;
        float m = e_val;
#pragma unroll
        for (int o = 32; o; o >>= 1) m = fmaxf(m, shx(m, o));
        if (lane == 0) sc[8 + wid] = m; }
    __syncthreads();
    const float emax = fmaxf(fmaxf(sc[8], sc[9]), fmaxf(sc[10], sc[11])), Btot = sc[0] + sc[1] + sc[2] + sc[3];
    if (tid < 256) wv[idx] = __expf(e_val - emax);
    if (tid == 0) { JS[sidx * 2] = Btot; JS[sidx * 2 + 1] = Btot + emax; }
    __syncthreads();
    f32x4 acc[2][8];
#pragma unroll
    for (int a = 0; a < 2; ++a)
#pragma unroll
        for (int n = 0; n < 8; ++n) acc[a][n] = (f32x4){0.f, 0.f, 0.f, 0.f};
    float dn_acc = 0.f;
    const int seq_lo = (J == 0) ? 0 : 256, seq_hi = (J == 0) ? 256 : 4352;
    bf16_t* QC = (bf16_t*)(p.ws + WS_QC); bf16_t* KC = (bf16_t*)(p.ws + WS_KC); bf16_t* VT = (bf16_t*)(p.ws + WS_VT);
#pragma unroll 1
    for (int sb = 0; sb < 4; ++sb) {
        u32x4 rv[4];
        { const bf16_t* vsrc = P + (size_t)pos_row(b, J * 256 + sb * 64 + (tid & 63)) * NPC + 1024 + h * 256 + (tid >> 6) * 32;
#pragma unroll
          for (int i = 0; i < 4; ++i) rv[i] = *(const u32x4*)(vsrc + 8 * i); }
        { const int s = tid & 63, dg = __builtin_amdgcn_readfirstlane(tid >> 6), pl = sb * 64 + s, pp = J * 256 + pl;
#pragma unroll 1
          for (int which = (dir == 0 ? 0 : 1); which < 2; ++which) {
              const int cbase = which * 512 + h * 128 + dg * 16;
              float a[16];
#pragma unroll
              for (int i = 0; i < 16; i += 4) { const float4 bb = *(const float4*)(p.cqb + l * 1024 + cbase + i); a[i] = bb.x; a[i + 1] = bb.y; a[i + 2] = bb.z; a[i + 3] = bb.w; }
#pragma unroll
              for (int j = 0; j < 4; ++j) { const int pq = pp - 1 + j;
                  if (pq >= seq_lo && pq < seq_hi) { const bf16_t* src = P + (size_t)pos_row(b, pq) * NPC + cbase; const float* wp = p.cqw + (size_t)(l * 4 + j) * 1024 + cbase;
#pragma unroll
                      for (int i8 = 0; i8 < 2; ++i8) { const u32x4 w = *(const u32x4*)(src + 8 * i8); const float4 w0 = *(const float4*)(wp + 8 * i8), w1 = *(const float4*)(wp + 8 * i8 + 4);
                          a[8 * i8 + 0] += w0.x * bflo(w.x); a[8 * i8 + 1] += w0.y * bfhi(w.x); a[8 * i8 + 2] += w0.z * bflo(w.y); a[8 * i8 + 3] += w0.w * bfhi(w.y);
                          a[8 * i8 + 4] += w1.x * bflo(w.z); a[8 * i8 + 5] += w1.y * bfhi(w.z); a[8 * i8 + 6] += w1.z * bflo(w.w); a[8 * i8 + 7] += w1.w * bfhi(w.w); } } }
              const float scale = which ? 0.08838834764831845f : 1.f;
#pragma unroll
              for (int i = 0; i < 16; ++i) a[i] = a[i] * sigm(a[i]) * scale;
              u32x4 o0, o1; o0.x = pk2(a[0], a[1]); o0.y = pk2(a[2], a[3]); o0.z = pk2(a[4], a[5]); o0.w = pk2(a[6], a[7]);
              o1.x = pk2(a[8], a[9]); o1.y = pk2(a[10], a[11]); o1.z = pk2(a[12], a[13]); o1.w = pk2(a[14], a[15]);
              if (which == 0) { bf16_t* dst = QC + ((size_t)bh * 4352 + pp) * 128 + dg * 16; *(u32x4*)dst = o0; *(u32x4*)(dst + 8) = o1; }
              else { if (dir == 0) { bf16_t* dst = KC + ((size_t)bh * 4352 + pp) * 128 + dg * 16; *(u32x4*)dst = o0; *(u32x4*)(dst + 8) = o1; }
                  const float ws_ = wv[pl];
#pragma unroll
                  for (int i = 0; i < 16; ++i) Ktw[(dg * 16 + i) * 72 + s] = (bf16_t)f2bf(bf2f(f2bf(a[i])) * ws_); }
          } }
        { const int s = tid & 63, vg = tid >> 6;
#pragma unroll
          for (int i = 0; i < 4; ++i) { const u32x4 w = rv[i];
              Vts[(vg * 32 + 8 * i + 0) * 72 + s] = (bf16_t)(w.x & 0xffff); Vts[(vg * 32 + 8 * i + 1) * 72 + s] = (bf16_t)(w.x >> 16);
              Vts[(vg * 32 + 8 * i + 2) * 72 + s] = (bf16_t)(w.y & 0xffff); Vts[(vg * 32 + 8 * i + 3) * 72 + s] = (bf16_t)(w.y >> 16);
              Vts[(vg * 32 + 8 * i + 4) * 72 + s] = (bf16_t)(w.z & 0xffff); Vts[(vg * 32 + 8 * i + 5) * 72 + s] = (bf16_t)(w.z >> 16);
              Vts[(vg * 32 + 8 * i + 6) * 72 + s] = (bf16_t)(w.w & 0xffff); Vts[(vg * 32 + 8 * i + 7) * 72 + s] = (bf16_t)(w.w >> 16); } }
        __syncthreads();
        if (dir == 0) { const int v = tid >> 1, half = tid & 1; bf16_t* dst = VT + ((((size_t)bh * 17 + J) * 4 + sb) * 256 + v) * 64 + half * 32;
#pragma unroll
            for (int i = 0; i < 4; ++i) *(u32x4*)(dst + 8 * i) = *(LAS u32x4*)(Vts + v * 72 + half * 32 + 8 * i); }
        if (tid < 128) { float sum = 0.f;
#pragma unroll
            for (int i = 0; i < 8; ++i) { const u32x4 w = *(LAS u32x4*)(Ktw + tid * 72 + 8 * i); sum += bflo(w.x) + bfhi(w.x) + bflo(w.y) + bfhi(w.y) + bflo(w.z) + bfhi(w.z) + bflo(w.w) + bfhi(w.w); }
            dn_acc += sum; }
#pragma unroll 1
        for (int ks = 0; ks < 2; ++ks) { bf16x8 A[2];
#pragma unroll
            for (int mt = 0; mt < 2; ++mt) A[mt] = *(LAS bf16x8*)(Vts + (32 * wid + 16 * mt + r) * 72 + 32 * ks + 8 * q);
#pragma unroll
            for (int nt = 0; nt < 8; ++nt) { const bf16x8 B = *(LAS bf16x8*)(Ktw + (16 * nt + r) * 72 + 32 * ks + 8 * q);
                acc[0][nt] = MFMA16(B, A[0], acc[0][nt]); acc[1][nt] = MFMA16(B, A[1], acc[1][nt]); } }
        __syncthreads();
    }
    bf16_t* DC = (bf16_t*)(p.ws + WS_DC) + (size_t)sidx * 32768;
#pragma unroll
    for (int mt = 0; mt < 2; ++mt)
#pragma unroll
        for (int nt = 0; nt < 8; ++nt) { u32x2 w; w.x = pk2(acc[mt][nt][0], acc[mt][nt][1]); w.y = pk2(acc[mt][nt][2], acc[mt][nt][3]);
            *(u32x2*)(DC + (32 * wid + 16 * mt + r) * 128 + 16 * nt + 4 * q) = w; }
    if (tid < 128) ((float*)(p.ws + WS_DN))[(size_t)sidx * 128 + tid] = dn_acc;
}

DI void phase_m2(const Params& p) {
    const float* JS = (const float*)(p.ws + WS_JS); const bf16_t* DC = (const bf16_t*)(p.ws + WS_DC); const float* DN = (const float*)(p.ws + WS_DN);
    bf16_t* CIN = (bf16_t*)(p.ws + WS_CIN); float* NIN = (float*)(p.ws + WS_NIN); float* MIN_ = (float*)(p.ws + WS_MIN);
    for (int item = lbid() * 512 + ltid(); item < 131072 + 512; item += gridDim.x * 512) {
        const bool isn = item >= 131072; int chain, off;
        if (!isn) { chain = item >> 13; off = (item & 8191) * 4; } else { const int it = item - 131072; chain = it >> 5; off = (it & 31) * 4; }
        const int dir = chain & 1;
        float4 C = make_float4(0.f, 0.f, 0.f, 0.f); float m = -1e30f;
#pragma unroll
        for (int step = 0; step < 17; ++step) {
            const int J = step == 0 ? 0 : (dir ? 17 - step : step), sidx = chain * 17 + J;
            if (!isn) { u32x2 w; w.x = pk2(C.x, C.y); w.y = pk2(C.z, C.w); *(u32x2*)(CIN + (size_t)sidx * 32768 + off) = w; if (off == 0) MIN_[sidx] = m; }
            else *(float4*)(NIN + (size_t)sidx * 128 + off) = C;
            const float Bt = JS[sidx * 2], ml = JS[sidx * 2 + 1], mn = fmaxf(Bt + m, ml), a = __expf(Bt + m - mn), bb = __expf(ml - mn);
            float4 d;
            if (isn) d = *(const float4*)(DN + (size_t)sidx * 128 + off);
            else { const u32x2 w = *(const u32x2*)(DC + (size_t)sidx * 32768 + off); d = make_float4(bflo(w.x), bfhi(w.x), bflo(w.y), bfhi(w.y)); }
            C.x = a * C.x + bb * d.x; C.y = a * C.y + bb * d.y; C.z = a * C.z + bb * d.z; C.w = a * C.w + bb * d.w; m = mn;
        }
    }
}

DI void m3_task(LAS unsigned char* lds, const Params& p, int l, int task) {
    const int tb = task & 3, J = (task >> 2) % 17, bh = (task >> 2) / 17, b = bh >> 2, h = bh & 3;
    const int tid = ltid(), wid = tid >> 6, lane = tid & 63, r = lane & 15, q = lane >> 4;
    LAS bf16_t* Qs = (LAS bf16_t*)lds;
    LAS bf16_t* Ks = (LAS bf16_t*)(lds + 17408);
    LAS bf16_t* Vts = (LAS bf16_t*)(lds + 34816);
    LAS bf16_t* Ps = (LAS bf16_t*)(lds + 71680);
    LAS float* es = (LAS float*)(lds + 80896);
    LAS float* Mt = (LAS float*)(lds + 81920); LAS float* inter = (LAS float*)(lds + 82176); LAS float* dfl = (LAS float*)(lds + 82432);
    LAS float* nqi = (LAS float*)(lds + 82688); LAS float* dinv = (LAS float*)(lds + 82944); LAS float* rinv = (LAS float*)(lds + 83200);
    LAS float* rs2 = (LAS float*)(lds + 83456);
    LAS float* ssq = (LAS float*)(lds + 83968);
    const bf16_t* QC = (const bf16_t*)(p.ws + WS_QC); const bf16_t* KC = (const bf16_t*)(p.ws + WS_KC); const bf16_t* VT = (const bf16_t*)(p.ws + WS_VT);
    const float* EG = (const float*)(p.ws + WS_EG); const float* BG = (const float*)(p.ws + WS_BG);
    { const int t = tid >> 3, part = tid & 7; const bf16_t* src = QC + ((size_t)bh * 4352 + J * 256 + tb * 64 + t) * 128 + part * 16;
      *(LAS u32x4*)(Qs + t * 136 + part * 16) = *(const u32x4*)src; *(LAS u32x4*)(Qs + t * 136 + part * 16 + 8) = *(const u32x4*)(src + 8); }
    f32x4 H[4][2];
#pragma unroll
    for (int a = 0; a < 4; ++a) { H[a][0] = (f32x4){0.f, 0.f, 0.f, 0.f}; H[a][1] = (f32x4){0.f, 0.f, 0.f, 0.f}; }
#pragma unroll 1
    for (int dir = 0; dir < 2; ++dir) {
        const int chain = bh * 2 + dir, sidx = chain * 17 + J;
        const float m_in = ((const float*)(p.ws + WS_MIN))[sidx];
        const int sb_lo = dir == 0 ? 0 : tb, sb_hi = dir == 0 ? tb : 3;
        u32x4 kr[2], vr[4];
#define M3_LOADKV(sbx) do { const bf16_t* ksrc = KC + ((size_t)bh * 4352 + J * 256 + (sbx) * 64 + (tid >> 3)) * 128 + (tid & 7) * 16; kr[0] = *(const u32x4*)ksrc; kr[1] = *(const u32x4*)(ksrc + 8); \
        const bf16_t* vsrc = VT + ((((size_t)bh * 17 + J) * 4 + (sbx)) * 256 + (tid >> 1)) * 64 + (tid & 1) * 32; vr[0] = *(const u32x4*)vsrc; vr[1] = *(const u32x4*)(vsrc + 8); vr[2] = *(const u32x4*)(vsrc + 16); vr[3] = *(const u32x4*)(vsrc + 24); } while (0)
        M3_LOADKV(sb_lo);
        if (tid < 256) es[tid] = EG[(size_t)chain * 4352 + J * 256 + tid];
        float bgv = 0.f; if (tid < 64) bgv = BG[(size_t)chain * 4352 + J * 256 + tb * 64 + tid];
        float4 nv[4]; { const float* nin = (const float*)(p.ws + WS_NIN) + (size_t)sidx * 128 + (tid & 7) * 16;
#pragma unroll
            for (int i = 0; i < 4; ++i) nv[i] = *(const float4*)(nin + 4 * i); }
        __syncthreads();
        if (tid < 64) { const int T = tb * 64 + tid; float v = es[T], oth = -3e38f;
            if (dir == 0) {
#pragma unroll
                for (int o = 1; o < 64; o <<= 1) { const float t2 = __shfl_up(v, o); if (lane >= o) v = fmaxf(v, t2); }
                for (int k = 0; k < tb; ++k) oth = fmaxf(oth, es[k * 64 + lane]);
            } else {
#pragma unroll
                for (int o = 1; o < 64; o <<= 1) { const float t2 = __shfl_down(v, o); if (lane + o < 64) v = fmaxf(v, t2); }
                for (int k = tb + 1; k < 4; ++k) oth = fmaxf(oth, es[k * 64 + lane]);
            }
#pragma unroll
            for (int o = 32; o; o >>= 1) oth = fmaxf(oth, shx(oth, o));
            const float pm = fmaxf(v, oth);
            const float M = fmaxf(m_in, pm); Mt[tid] = M; inter[tid] = __expf(m_in - M);
            dfl[tid] = __expf(-(bgv + M)); }
        { const int t = tid >> 3, part = tid & 7; float s = 0.f;
#pragma unroll
          for (int i = 0; i < 4; ++i) { const u32x2 qw = *(LAS u32x2*)(Qs + t * 136 + part * 16 + 4 * i);
              s += bflo(qw.x) * nv[i].x + bfhi(qw.x) * nv[i].y + bflo(qw.y) * nv[i].z + bfhi(qw.y) * nv[i].w; }
          s += shx(s, 1); s += shx(s, 2); s += shx(s, 4); if (part == 0) nqi[t] = s; }
        __syncthreads();
        f32x4 O[4][2];
#pragma unroll
        for (int a = 0; a < 4; ++a) { O[a][0] = (f32x4){0.f, 0.f, 0.f, 0.f}; O[a][1] = (f32x4){0.f, 0.f, 0.f, 0.f}; }
        { const bf16_t* Cg = (const bf16_t*)(p.ws + WS_CIN) + (size_t)sidx * 32768;
#pragma unroll
          for (int ks = 0; ks < 4; ++ks) { bf16x8 Bf[2];
#pragma unroll
              for (int nt = 0; nt < 2; ++nt) Bf[nt] = *(const bf16x8*)(Cg + (size_t)(32 * wid + 16 * nt + r) * 128 + 32 * ks + 8 * q);
#pragma unroll
              for (int mt = 0; mt < 4; ++mt) { const bf16x8 A = *(LAS bf16x8*)(Qs + (16 * mt + r) * 136 + 32 * ks + 8 * q); O[mt][0] = MFMA16(Bf[0], A, O[mt][0]); O[mt][1] = MFMA16(Bf[1], A, O[mt][1]); } }
#pragma unroll
          for (int mt = 0; mt < 4; ++mt) { const float it = inter[16 * mt + r]; O[mt][0] *= it; O[mt][1] *= it; } }
        float rsum[4] = {0.f, 0.f, 0.f, 0.f};
#pragma unroll 1
        for (int sb = sb_lo; sb <= sb_hi; ++sb) {
            { const int t = tid >> 3, part = tid & 7; *(LAS u32x4*)(Ks + t * 136 + part * 16) = kr[0]; *(LAS u32x4*)(Ks + t * 136 + part * 16 + 8) = kr[1]; }
            { const int v = tid >> 1, half = tid & 1;
#pragma unroll
              for (int i = 0; i < 4; ++i) *(LAS u32x4*)(Vts + v * 72 + half * 32 + 8 * i) = vr[i]; }
            __syncthreads();
            if (sb < sb_hi) M3_LOADKV(sb + 1);
            { const int mt = wid & 3, ntb = (wid >> 2) * 2; f32x4 S[2]; S[0] = (f32x4){0.f, 0.f, 0.f, 0.f}; S[1] = S[0];
#pragma unroll
              for (int ks = 0; ks < 4; ++ks) { const bf16x8 A = *(LAS bf16x8*)(Qs + (16 * mt + r) * 136 + 32 * ks + 8 * q);
#pragma unroll
                  for (int n2 = 0; n2 < 2; ++n2) { const bf16x8 B = *(LAS bf16x8*)(Ks + (16 * (ntb + n2) + r) * 136 + 32 * ks + 8 * q); S[n2] = MFMA16(A, B, S[n2]); } }
#pragma unroll
              for (int n2 = 0; n2 < 2; ++n2)
#pragma unroll
                  for (int j = 0; j < 4; ++j) { const int t = 16 * mt + 4 * q + j, s = 16 * (ntb + n2) + r, Tg = tb * 64 + t, Sg = sb * 64 + s;
                      const bool ok = dir == 0 ? (Sg <= Tg) : (Sg >= Tg);
                      const float pv = ok ? S[n2][j] * __expf(fminf(es[Sg] - Mt[t], 0.f)) : 0.f;
                      rsum[j] += pv; Ps[t * 72 + s] = (bf16_t)f2bf(pv); } }
            __syncthreads();
#pragma unroll
            for (int ks = 0; ks < 2; ++ks) { bf16x8 Bf[2];
#pragma unroll
                for (int nt = 0; nt < 2; ++nt) Bf[nt] = *(LAS bf16x8*)(Vts + (32 * wid + 16 * nt + r) * 72 + 32 * ks + 8 * q);
#pragma unroll
                for (int mt = 0; mt < 4; ++mt) { const bf16x8 A = *(LAS bf16x8*)(Ps + (16 * mt + r) * 72 + 32 * ks + 8 * q); O[mt][0] = MFMA16(Bf[0], A, O[mt][0]); O[mt][1] = MFMA16(Bf[1], A, O[mt][1]); } }
            __syncthreads();
        }
#pragma unroll
        for (int j = 0; j < 4; ++j) { float v = rsum[j]; v += shx(v, 1); v += shx(v, 2); v += shx(v, 4); v += shx(v, 8);
            if (r == 0) rs2[(16 * (wid & 3) + 4 * q + j) * 2 + (wid >> 2)] = v; }
        __syncthreads();
        if (tid < 64) { const float nq = inter[tid] * nqi[tid] + rs2[2 * tid] + rs2[2 * tid + 1]; dinv[tid] = 1.f / fmaxf(fabsf(nq), dfl[tid]); }
        __syncthreads();
#pragma unroll
        for (int mt = 0; mt < 4; ++mt) { const float di = dinv[16 * mt + r]; H[mt][0] += O[mt][0] * di; H[mt][1] += O[mt][1] * di; }
        __syncthreads();
    }
#pragma unroll
    for (int mt = 0; mt < 4; ++mt) { float v = 0.f;
#pragma unroll
        for (int j = 0; j < 4; ++j) v += H[mt][0][j] * H[mt][0][j] + H[mt][1][j] * H[mt][1][j];
        v += shx(v, 16); v += shx(v, 32);
        if (q == 0) ssq[(16 * mt + r) * 8 + wid] = v; }
    __syncthreads();
    if (tid < 64) { float s = 0.f;
#pragma unroll
        for (int w = 0; w < 8; ++w) s += ssq[tid * 8 + w];
        rinv[tid] = rsqrtf(s * (1.f / 256.f) + 1e-6f); }
    __syncthreads();
    const bf16_t* P = (const bf16_t*)(p.ws + WS_P); bf16_t* Y = (bf16_t*)(p.ws + WS_Y);
#pragma unroll
    for (int mt = 0; mt < 4; ++mt) { const int t = 16 * mt + r; const size_t row = (size_t)pos_row(b, J * 256 + tb * 64 + t); const float ri = rinv[t];
#pragma unroll
        for (int nt = 0; nt < 2; ++nt) { const int col = h * 256 + 32 * wid + 16 * nt + 4 * q;
            const u32x2 ow = *(const u32x2*)(P + row * NPC + 2048 + col), zw = *(const u32x2*)(P + row * NPC + 3072 + col); const float4 gn = *(const float4*)(p.mng + l * 1024 + col);
            const float o0 = bflo(ow.x), o1 = bfhi(ow.x), o2 = bflo(ow.y), o3 = bfhi(ow.y), z0 = bflo(zw.x), z1 = bfhi(zw.x), z2 = bflo(zw.y), z3 = bfhi(zw.y);
            u32x2 yw; yw.x = pk2(H[mt][nt][0] * ri * gn.x * sigm(o0) * z0 * sigm(z0), H[mt][nt][1] * ri * gn.y * sigm(o1) * z1 * sigm(z1));
            yw.y = pk2(H[mt][nt][2] * ri * gn.z * sigm(o2) * z2 * sigm(z2), H[mt][nt][3] * ri * gn.w * sigm(o3) * z3 * sigm(z3));
            *(u32x2*)(Y + row * 2048 + col) = yw; } }
    __syncthreads();
}

DI void r_task(LAS unsigned char* lds, const Params& p, int l, int task, int mode, const int d0 = 0, const int d1 = 2) {
    const int g = task & 15, seg = task >> 4;
    const int tid = ltid(), wid = tid >> 6, lane = tid & 63, r = lane & 15, q = lane >> 4;
    int b, base_row, tok0, seqlen, s16 = 0;
    if (seg < 2) { b = seg; base_row = 8192 + b * 256; tok0 = 0; seqlen = 256; } else { const int si = seg - 2; b = si >> 4; s16 = si & 15; base_row = b * 4096; tok0 = s16 * 256; seqlen = 4096; }
    LAS float* xcf = (LAS float*)lds;
    LAS bf16_t* xcb = (LAS bf16_t*)(lds + 66560);
    LAS float* wagg = (LAS float*)(lds + 103424);
    LAS float* hin = (LAS float*)(lds + 107520);
    const bf16_t* P = (const bf16_t*)(p.ws + WS_P);
    if (mode == 0) { const int t = tid & 255, half = __builtin_amdgcn_readfirstlane(tid >> 8), cb = 64 * g + half * 32;
      float a[32];
#pragma unroll
      for (int i = 0; i < 32; i += 4) { const float4 bb = *(const float4*)(p.crb + l * 1024 + cb + i); a[i] = bb.x; a[i + 1] = bb.y; a[i + 2] = bb.z; a[i + 3] = bb.w; }
#pragma unroll
      for (int j = 0; j < 4; ++j) { const int tk = tok0 + t - 1 + j;
          if (tk >= 0 && tk < seqlen) { const bf16_t* src = P + (size_t)(base_row + tk) * NPC + 4096 + cb; const float* wp = p.crw + (size_t)(l * 4 + j) * 1024 + cb;
#pragma unroll
              for (int i8 = 0; i8 < 4; ++i8) { const u32x4 w = *(const u32x4*)(src + 8 * i8); const float4 w0 = *(const float4*)(wp + 8 * i8), w1 = *(const float4*)(wp + 8 * i8 + 4);
                  a[8 * i8 + 0] += w0.x * bflo(w.x); a[8 * i8 + 1] += w0.y * bfhi(w.x); a[8 * i8 + 2] += w0.z * bflo(w.y); a[8 * i8 + 3] += w0.w * bfhi(w.y);
                  a[8 * i8 + 4] += w1.x * bflo(w.z); a[8 * i8 + 5] += w1.y * bfhi(w.z); a[8 * i8 + 6] += w1.z * bflo(w.w); a[8 * i8 + 7] += w1.w * bfhi(w.w); } } }
#pragma unroll
      for (int i = 0; i < 32; ++i) xcf[t * 65 + half * 32 + i] = a[i];
#pragma unroll
      for (int i8 = 0; i8 < 4; ++i8) { u32x4 w; w.x = pk2(a[8 * i8], a[8 * i8 + 1]); w.y = pk2(a[8 * i8 + 2], a[8 * i8 + 3]); w.z = pk2(a[8 * i8 + 4], a[8 * i8 + 5]); w.w = pk2(a[8 * i8 + 6], a[8 * i8 + 7]);
          *(LAS u32x4*)(xcb + t * 72 + half * 32 + 8 * i8) = w; } }
    __syncthreads();
    f32x4 Hs[2][4];
#pragma unroll
    for (int a = 0; a < 2; ++a)
#pragma unroll
        for (int n = 0; n < 4; ++n) Hs[a][n] = (f32x4){0.f, 0.f, 0.f, 0.f};
    const float2* RA = (const float2*)(p.ws + WS_RAGG);
#pragma unroll 1
    for (int dir = d0; dir < d1; ++dir) {
        if (mode == 1 && tid < 64) { float hh = 0.f;
            if (seg >= 2) { float2 au[17]; au[0] = RA[((size_t)b * 2 + dir) * 1024 + 64 * g + tid];
#pragma unroll
                for (int k = 0; k < 16; ++k) { const int sk = dir == 0 ? k : 15 - k; const bool use = dir == 0 ? (sk < s16) : (sk > s16);
                    au[1 + k] = use ? RA[((size_t)(2 + b * 16 + sk) * 2 + dir) * 1024 + 64 * g + tid] : make_float2(1.f, 0.f); }
#pragma unroll
                for (int k = 0; k < 17; ++k) hh = au[k].x * hh + au[k].y; }
            hin[tid] = hh; }
        const bf16_t* Wr = (const bf16_t*)(p.ws + WS_WRT) + ((size_t)((l * 2 + dir) * 2 + 0) * 16 + g) * 4096; const bf16_t* Wi = Wr + (size_t)16 * 4096;
        unsigned* LU = (unsigned*)(p.ws + WS_LU) + ((size_t)dir * NTOK + base_row + tok0) * 1024 + 64 * g;
        f32x4 R[2][4], I[2][4];
        if (mode == 1) {
#pragma unroll
            for (int mt = 0; mt < 2; ++mt)
#pragma unroll
                for (int nt = 0; nt < 4; ++nt)
#pragma unroll
                    for (int j = 0; j < 4; ++j) { const unsigned w = LU[(size_t)(32 * wid + 16 * mt + 4 * q + j) * 1024 + 16 * nt + r]; R[mt][nt][j] = __builtin_amdgcn_exp2f(bflo(w)); I[mt][nt][j] = bfhi(w); }
        } else {
#pragma unroll
        for (int a = 0; a < 2; ++a)
#pragma unroll
            for (int n = 0; n < 4; ++n) { R[a][n] = (f32x4){0.f, 0.f, 0.f, 0.f}; I[a][n] = (f32x4){0.f, 0.f, 0.f, 0.f}; }
#pragma unroll
        for (int ks = 0; ks < 2; ++ks) { bf16x8 A[2];
#pragma unroll
            for (int mt = 0; mt < 2; ++mt) A[mt] = *(LAS bf16x8*)(xcb + (32 * wid + 16 * mt + r) * 72 + 32 * ks + 8 * q);
#pragma unroll
            for (int nt = 0; nt < 4; ++nt) { const bf16x8 br = *(const bf16x8*)(Wr + (16 * nt + r) * 64 + 32 * ks + 8 * q), bi = *(const bf16x8*)(Wi + (16 * nt + r) * 64 + 32 * ks + 8 * q);
                R[0][nt] = MFMA16(A[0], br, R[0][nt]); R[1][nt] = MFMA16(A[1], br, R[1][nt]); I[0][nt] = MFMA16(A[0], bi, I[0][nt]); I[1][nt] = MFMA16(A[1], bi, I[1][nt]); } }
#pragma unroll
        for (int nt = 0; nt < 4; ++nt) { const int ch = 64 * g + 16 * nt + r;
            const float br = p.b_rg[(size_t)((l * 2 + dir) * 2 + 0) * 1024 + ch], bi = p.b_rg[(size_t)((l * 2 + dir) * 2 + 1) * 1024 + ch], lm = p.lam[(size_t)(l * 2 + dir) * 1024 + ch];
            const float sp = fmaxf(-lm, 0.f) + __logf(1.f + __expf(-fabsf(lm)));
            const float nbr = -1.4426950408889634f * br, nbi = -1.4426950408889634f * bi, c2 = -8.f * 1.4426950408889634f * sp, ct = 16.f * sp;
#pragma unroll
            for (int mt = 0; mt < 2; ++mt)
#pragma unroll
                for (int j = 0; j < 4; ++j) { const int t = 32 * wid + 16 * mt + 4 * q + j;
                    const float d1 = 1.f + __builtin_amdgcn_exp2f(fminf(__builtin_fmaf(R[mt][nt][j], -1.4426950408889634f, nbr), 43.f));
                    const float d2 = 1.f + __builtin_amdgcn_exp2f(fminf(__builtin_fmaf(I[mt][nt][j], -1.4426950408889634f, nbi), 43.f));
                    const float rc = __builtin_amdgcn_rcpf(d1 * d2), rr = d2 * rc, ii = d1 * rc, la2 = rr * c2, a = __builtin_amdgcn_exp2f(la2), tt = rr * ct;
                    const float om = tt < 1e-3f ? tt * (1.f - 0.5f * tt) : __builtin_fmaf(-a, a, 1.f);
                    const float uu = __builtin_amdgcn_sqrtf(om) * ii * xcf[t * 65 + 16 * nt + r];
                    R[mt][nt][j] = a; I[mt][nt][j] = uu; LU[(size_t)t * 1024 + 16 * nt + r] = pk2(la2, uu); } }
        }
        float pA[2][4], pU[2][4], tA[2][4], tU[2][4];
#pragma unroll
        for (int mt = 0; mt < 2; ++mt)
#pragma unroll
            for (int nt = 0; nt < 4; ++nt) { const f32x4 a = R[mt][nt], u = I[mt][nt]; float A_, U_;
                if (dir == 0) { A_ = a[0] * a[1] * a[2] * a[3]; U_ = ((u[0] * a[1] + u[1]) * a[2] + u[2]) * a[3] + u[3]; }
                else { A_ = a[0] * a[1] * a[2] * a[3]; U_ = ((u[3] * a[2] + u[2]) * a[1] + u[1]) * a[0] + u[0]; }
                float Ak[4], Uk[4];
#pragma unroll
                for (int k = 0; k < 4; ++k) { Ak[k] = __shfl(A_, r + 16 * k); Uk[k] = __shfl(U_, r + 16 * k); }
                float PA = 1.f, PU = 0.f, TA = 1.f, TU = 0.f;
                if (dir == 0) {
#pragma unroll
                    for (int k = 0; k < 4; ++k) { if (k < q) { PU = PU * Ak[k] + Uk[k]; PA *= Ak[k]; } TU = TU * Ak[k] + Uk[k]; TA *= Ak[k]; }
                } else {
#pragma unroll
                    for (int k = 3; k >= 0; --k) { if (k > q) { PU = PU * Ak[k] + Uk[k]; PA *= Ak[k]; } TU = TU * Ak[k] + Uk[k]; TA *= Ak[k]; }
                }
                pA[mt][nt] = PA; pU[mt][nt] = PU; tA[mt][nt] = TA; tU[mt][nt] = TU; }
#pragma unroll
        for (int nt = 0; nt < 4; ++nt) {
            const float WA = tA[0][nt] * tA[1][nt], WU = dir == 0 ? tU[0][nt] * tA[1][nt] + tU[1][nt] : tU[1][nt] * tA[0][nt] + tU[0][nt];
            if (q == 0) { wagg[(wid * 2 + 0) * 64 + 16 * nt + r] = WA; wagg[(wid * 2 + 1) * 64 + 16 * nt + r] = WU; } }
        __syncthreads();
        if (mode == 0) {
            if (tid < 64) { float A_ = 1.f, U_ = 0.f;
#pragma unroll
                for (int kk = 0; kk < 8; ++kk) { const int w = dir == 0 ? kk : 7 - kk; const float a = wagg[(w * 2 + 0) * 64 + tid], u = wagg[(w * 2 + 1) * 64 + tid]; U_ = U_ * a + u; A_ *= a; }
                ((float2*)(p.ws + WS_RAGG))[((size_t)seg * 2 + dir) * 1024 + 64 * g + tid] = make_float2(A_, U_); }
        } else {
#pragma unroll
            for (int nt = 0; nt < 4; ++nt) { float hh = hin[16 * nt + r];
                if (dir == 0) { for (int w = 0; w < wid; ++w) hh = wagg[(w * 2 + 0) * 64 + 16 * nt + r] * hh + wagg[(w * 2 + 1) * 64 + 16 * nt + r]; }
                else { for (int w = 7; w > wid; --w) hh = wagg[(w * 2 + 0) * 64 + 16 * nt + r] * hh + wagg[(w * 2 + 1) * 64 + 16 * nt + r]; }
                if (dir == 0) {
#pragma unroll
                    for (int mt = 0; mt < 2; ++mt) { float hv = pA[mt][nt] * hh + pU[mt][nt];
#pragma unroll
                        for (int j = 0; j < 4; ++j) { hv = R[mt][nt][j] * hv + I[mt][nt][j]; Hs[mt][nt][j] += hv; }
                        hh = tA[mt][nt] * hh + tU[mt][nt]; }
                } else {
#pragma unroll
                    for (int mt = 1; mt >= 0; --mt) { float hv = pA[mt][nt] * hh + pU[mt][nt];
#pragma unroll
                        for (int j = 3; j >= 0; --j) { hv = R[mt][nt][j] * hv + I[mt][nt][j]; Hs[mt][nt][j] += hv; }
                        hh = tA[mt][nt] * hh + tU[mt][nt]; }
                } }
        }
        __syncthreads();
    }
    if (mode == 1) { bf16_t* Y = (bf16_t*)(p.ws + WS_Y);
#pragma unroll
        for (int mt = 0; mt < 2; ++mt)
#pragma unroll
            for (int nt = 0; nt < 4; ++nt)
#pragma unroll
                for (int j = 0; j < 4; ++j) { const size_t row = (size_t)(base_row + tok0 + 32 * wid + 16 * mt + 4 * q + j); const int ch = 64 * g + 16 * nt + r;
                    const float z = bf2f(P[row * NPC + 5120 + ch]); Y[row * 2048 + 1024 + ch] = (bf16_t)f2bf(Hs[mt][nt][j] * z * sigm(z)); } }
    __syncthreads();
}

#if SINGLE_LAUNCH

DI void r0s_task(LAS unsigned char* lds, const Params& p, int l, int task) {
    const int g = task & 15, seg = task >> 4;
    const int tid = ltid(), wid = tid >> 6, lane = tid & 63, r = lane & 15, q = lane >> 4;
    int b, base_row, tok0, seqlen;
    if (seg < 2) { b = seg; base_row = 8192 + b * 256; tok0 = 0; seqlen = 256; } else { const int si = seg - 2; b = si >> 4; base_row = b * 4096; tok0 = (si & 15) * 256; seqlen = 4096; }
    LAS float* xcf = (LAS float*)lds;
    LAS bf16_t* GR = (LAS bf16_t*)(lds + 69632);
    LAS bf16_t* GI = (LAS bf16_t*)(lds + 69632 + 32768);
    LAS float* agg = (LAS float*)(lds + 69632 + 65536);
    const bf16_t* P = (const bf16_t*)(p.ws + WS_P);
    { const int t = tid >> 1, half = tid & 1, cb = 64 * g + half * 32;
      float a[32];
#pragma unroll
      for (int i = 0; i < 32; i += 4) { const float4 bb = *(const float4*)(p.crb + l * 1024 + cb + i); a[i] = bb.x; a[i + 1] = bb.y; a[i + 2] = bb.z; a[i + 3] = bb.w; }
#pragma unroll
      for (int j = 0; j < 4; ++j) { const int tk = tok0 + t - 1 + j;
          if (tk >= 0 && tk < seqlen) { const bf16_t* src = P + (size_t)(base_row + tk) * NPC + 4096 + cb; const float* wp = p.crw + (size_t)(l * 4 + j) * 1024 + cb;
#pragma unroll
              for (int i8 = 0; i8 < 4; ++i8) { const u32x4 w = *(const u32x4*)(src + 8 * i8); const float4 w0 = *(const float4*)(wp + 8 * i8), w1 = *(const float4*)(wp + 8 * i8 + 4);
                  a[8 * i8 + 0] += w0.x * bflo(w.x); a[8 * i8 + 1] += w0.y * bfhi(w.x); a[8 * i8 + 2] += w0.z * bflo(w.y); a[8 * i8 + 3] += w0.w * bfhi(w.y);
                  a[8 * i8 + 4] += w1.x * bflo(w.z); a[8 * i8 + 5] += w1.y * bfhi(w.z); a[8 * i8 + 6] += w1.z * bflo(w.w); a[8 * i8 + 7] += w1.w * bfhi(w.w); } } }
#pragma unroll
      for (int i = 0; i < 32; i += 4) *(LAS f32x4*)(xcf + t * 68 + half * 32 + i) = (f32x4){a[i], a[i + 1], a[i + 2], a[i + 3]}; }
    __syncthreads();
    bf16x8 Af[2][2];
#pragma unroll
    for (int ks = 0; ks < 2; ++ks)
#pragma unroll
        for (int mt = 0; mt < 2; ++mt) { const LAS float* src = xcf + (32 * wid + 16 * mt + r) * 68 + 32 * ks + 8 * q; const f32x4 x0 = *(const LAS f32x4*)src, x1 = *(const LAS f32x4*)(src + 4);
            u32x4 w; w.x = pk2(x0[0], x0[1]); w.y = pk2(x0[2], x0[3]); w.z = pk2(x1[0], x1[1]); w.w = pk2(x1[2], x1[3]); Af[ks][mt] = __builtin_bit_cast(bf16x8, w); }
#pragma unroll 1
    for (int dir = 0; dir < 2; ++dir) {
        const bf16_t* Wr = (const bf16_t*)(p.ws + WS_WRT) + ((size_t)((l * 2 + dir) * 2 + 0) * 16 + g) * 4096; const bf16_t* Wi = Wr + (size_t)16 * 4096;
        { f32x4 R[2][4], I[2][4];
#pragma unroll
          for (int a = 0; a < 2; ++a)
#pragma unroll
              for (int n = 0; n < 4; ++n) { R[a][n] = (f32x4){0.f, 0.f, 0.f, 0.f}; I[a][n] = (f32x4){0.f, 0.f, 0.f, 0.f}; }
#pragma unroll
          for (int ks = 0; ks < 2; ++ks)
#pragma unroll
              for (int nt = 0; nt < 4; ++nt) { const bf16x8 br = *(const bf16x8*)(Wr + (16 * nt + r) * 64 + 32 * ks + 8 * q), bi = *(const bf16x8*)(Wi + (16 * nt + r) * 64 + 32 * ks + 8 * q);
                  R[0][nt] = MFMA16(Af[ks][0], br, R[0][nt]); R[1][nt] = MFMA16(Af[ks][1], br, R[1][nt]); I[0][nt] = MFMA16(Af[ks][0], bi, I[0][nt]); I[1][nt] = MFMA16(Af[ks][1], bi, I[1][nt]); }
#pragma unroll
          for (int mt = 0; mt < 2; ++mt)
#pragma unroll
              for (int nt = 0; nt < 4; ++nt)
#pragma unroll
                  for (int j = 0; j < 4; ++j) { const int o = (32 * wid + 16 * mt + 4 * q + j) * 64 + 16 * nt + r; GR[o] = (bf16_t)f2bf(R[mt][nt][j]); GI[o] = (bf16_t)f2bf(I[mt][nt][j]); } }
        __syncthreads();
        { const int c = lane, ch = 64 * g + c;
          const float br = p.b_rg[(size_t)((l * 2 + dir) * 2 + 0) * 1024 + ch], bi = p.b_rg[(size_t)((l * 2 + dir) * 2 + 1) * 1024 + ch], lm = p.lam[(size_t)(l * 2 + dir) * 1024 + ch];
          const float sp = fmaxf(-lm, 0.f) + __logf(1.f + __expf(-fabsf(lm)));
          unsigned* LU = (unsigned*)(p.ws + WS_LU) + ((size_t)dir * NTOK + base_row + tok0) * 1024 + ch;
          float Aa = 1.f, Uu = 0.f;
#pragma unroll 4
          for (int i = 0; i < 32; ++i) { const int t = 32 * wid + (dir == 0 ? i : 31 - i);
              const float d1 = 1.f + __expf(-fmaxf(bf2f(GR[t * 64 + c]) + br, -30.f)), d2 = 1.f + __expf(-fmaxf(bf2f(GI[t * 64 + c]) + bi, -30.f)), rc = __builtin_amdgcn_rcpf(d1 * d2);
              const float rr = d2 * rc, ii = d1 * rc, la = -8.f * rr * sp, a = __expf(la);
              const float uu = __builtin_amdgcn_sqrtf(one_m_expneg(-2.f * la, a * a)) * ii * xcf[t * 68 + c];
              LU[(size_t)t * 1024] = pk2(la, uu);
              Uu = Uu * a + uu; Aa *= a; }
          agg[(wid * 2 + 0) * 64 + c] = Aa; agg[(wid * 2 + 1) * 64 + c] = Uu; }
        __syncthreads();
        if (tid < 64) { float A_ = 1.f, U_ = 0.f;
#pragma unroll
            for (int kk = 0; kk < 8; ++kk) { const int w = dir == 0 ? kk : 7 - kk; const float a = agg[(w * 2 + 0) * 64 + tid], u = agg[(w * 2 + 1) * 64 + tid]; U_ = U_ * a + u; A_ *= a; }
            ((float2*)(p.ws + WS_RAGG))[((size_t)seg * 2 + dir) * 1024 + 64 * g + tid] = make_float2(A_, U_); }
        __syncthreads();
    }
}

DI void rs_task(LAS unsigned char* lds, const Params& p, int l, int task) {
    const int cg4 = task & 3, seg = task >> 2;
    const int tid = ltid();
    int b, base_row, tok0, s16 = 0;
    if (seg < 2) { b = seg; base_row = 8192 + b * 256; tok0 = 0; } else { const int si = seg - 2; b = si >> 4; s16 = si & 15; base_row = b * 4096; tok0 = s16 * 256; }
    LAS bf16_t* Hs = (LAS bf16_t*)lds;
    const int c = tid & 255, dir = tid >> 8, ch = 256 * cg4 + c;
    float h = 0.f;
    { const float2* RA = (const float2*)(p.ws + WS_RAGG);
      if (seg >= 2) { float2 au[17]; au[0] = RA[((size_t)b * 2 + dir) * 1024 + ch];
#pragma unroll
          for (int k = 0; k < 16; ++k) { const int sk = dir == 0 ? k : 15 - k; const bool use = dir == 0 ? (sk < s16) : (sk > s16);
              au[1 + k] = use ? RA[((size_t)(2 + b * 16 + sk) * 2 + dir) * 1024 + ch] : make_float2(1.f, 0.f); }
#pragma unroll
          for (int k = 0; k < 17; ++k) h = au[k].x * h + au[k].y; } }
    const unsigned* LU = (const unsigned*)(p.ws + WS_LU) + ((size_t)dir * NTOK + base_row + tok0) * 1024 + ch;
    LAS bf16_t* Hd = Hs + c;
    unsigned wa[32], wb[32];
#define RS_LOAD(dst, s0) _Pragma("unroll") for (int i = 0; i < 32; ++i) { const int t = dir == 0 ? (s0) + i : 255 - (s0) - i; dst[i] = LU[(size_t)t * 1024]; }
#define RS_SCAN(src, s0, ADD) _Pragma("unroll") for (int i = 0; i < 32; ++i) { const int t = dir == 0 ? (s0) + i : 255 - (s0) - i; h = __builtin_amdgcn_exp2f(bflo(src[i])) * h + bfhi(src[i]); \
        const float o_ = ADD ? h + bf2f(Hd[t * 256]) : h; Hd[t * 256] = (bf16_t)f2bf(o_); }
    RS_LOAD(wa, 0)
#pragma unroll 1
    for (int s0 = 0; s0 < 128; s0 += 64) { RS_LOAD(wb, s0 + 32) RS_SCAN(wa, s0, false) RS_LOAD(wa, s0 + 64) RS_SCAN(wb, s0 + 32, false) }
    __syncthreads();
#pragma unroll 1
    for (int s0 = 128; s0 < 256; s0 += 64) { RS_LOAD(wb, s0 + 32) RS_SCAN(wa, s0, true) if (s0 + 64 < 256) { RS_LOAD(wa, s0 + 64) } RS_SCAN(wb, s0 + 32, true) }
    __syncthreads();
    const bf16_t* P = (const bf16_t*)(p.ws + WS_P); bf16_t* Y = (bf16_t*)(p.ws + WS_Y);
#pragma unroll 2
    for (int i = 0; i < 16; ++i) { const int chunk = tid + 512 * i, t = chunk >> 5, c8 = (chunk & 31) * 8; const size_t row = (size_t)(base_row + tok0 + t);
        const u32x4 hh = *(LAS u32x4*)(Hs + t * 256 + c8), zz = *(const u32x4*)(P + row * NPC + 5120 + 256 * cg4 + c8);
        u32x4 o;
        { const float z0 = bflo(zz.x), z1 = bfhi(zz.x); o.x = pk2(bflo(hh.x) * z0 * sigm(z0), bfhi(hh.x) * z1 * sigm(z1)); }
        { const float z0 = bflo(zz.y), z1 = bfhi(zz.y); o.y = pk2(bflo(hh.y) * z0 * sigm(z0), bfhi(hh.y) * z1 * sigm(z1)); }
        { const float z0 = bflo(zz.z), z1 = bfhi(zz.z); o.z = pk2(bflo(hh.z) * z0 * sigm(z0), bfhi(hh.z) * z1 * sigm(z1)); }
        { const float z0 = bflo(zz.w), z1 = bfhi(zz.w); o.w = pk2(bflo(hh.w) * z0 * sigm(z0), bfhi(hh.w) * z1 * sigm(z1)); }
        *(u32x4*)(Y + row * 2048 + 1024 + 256 * cg4 + c8) = o; }
    __syncthreads();
}

__device__ unsigned g_q[32 * 64];
DI int next_chunk(LAS unsigned char* lds, int qi, unsigned n) { asm volatile("" : "+s"(qi)); LAS int* slot = (LAS int*)(lds + LDS_BYTES - 64); if (ltid() == 0) *slot = (int)__hip_atomic_fetch_add(&g_q[qi * 64], n, __ATOMIC_RELAXED, __HIP_MEMORY_SCOPE_AGENT); __syncthreads(); return *slot; }
DI int next_task(LAS unsigned char* lds, int ph) { asm volatile("" : "+s"(ph)); LAS int* slot = (LAS int*)(lds + LDS_BYTES - 64); if (ltid() == 0) *slot = (int)gridDim.x + (int)__hip_atomic_fetch_add(&g_q[ph * 64], 1u, __ATOMIC_RELAXED, __HIP_MEMORY_SCOPE_AGENT); __syncthreads(); return *slot; }
#define XB_XCNT(j) (64 * (j))
#define XB_XSUB(j) (1024 + 64 * (j))
#define XB_XGEN(j) (2048 + 64 * (j))
#define XB_TOP 3072
#define XB_TOPGEN 3136
__device__ unsigned g_bar[3200];
DI unsigned xb_ld(unsigned* p) { return __hip_atomic_load(p, __ATOMIC_RELAXED, __HIP_MEMORY_SCOPE_AGENT); }
DI unsigned xb_add(unsigned* p, unsigned v) { return __hip_atomic_fetch_add(p, v, __ATOMIC_RELAXED, __HIP_MEMORY_SCOPE_AGENT); }
DI void xb_st(unsigned* p, unsigned v) { __hip_atomic_store(p, v, __ATOMIC_RELAXED, __HIP_MEMORY_SCOPE_AGENT); }
DI unsigned xb_xcc_id() { return (unsigned)__builtin_amdgcn_s_getreg((3 << 11) | 20) & 0xFu; }
#define XB_SPIN(cond) do { unsigned _sp = 0; while (cond) { __builtin_amdgcn_s_sleep(1); if (++_sp > (1u << 22)) break; } } while (0)
DI void grid_barrier_post() { if (ltid() == 0) { int z = 0; asm volatile("" : "+s"(z)); (void)xb_add(&g_bar[z + XB_XCNT(xb_xcc_id())], 1u); } }
DI void grid_barrier_clear_census() { if (lbid() == 0 && ltid() < 16) { int z = 0; asm volatile("" : "+s"(z)); xb_st(&g_bar[z + XB_XCNT(ltid())], 0u); } }
DI void grid_barrier(LAS unsigned char* lds) {
    asm volatile("s_waitcnt vmcnt(0)" ::: "memory");
    __syncthreads();
    if (ltid() == 0) {
        int z = 0; asm volatile("" : "+s"(z)); unsigned* bar = &g_bar[z];
        volatile LAS unsigned* st = (volatile LAS unsigned*)(lds + LDS_BYTES - 32);
        const unsigned x = xb_xcc_id(), G = gridDim.x;
        unsigned nloc = st[0], nx = st[1];
        if (nloc == 0u) {
            unsigned sum, cnt, mine, sp = 0u;
            for (;;) { sum = 0u; cnt = 0u; mine = 0u;
#pragma unroll
                for (unsigned j = 0; j < 16; ++j) { const unsigned c = xb_ld(&bar[XB_XCNT(j)]); sum += c; cnt += (c > 0u) ? 1u : 0u; mine = (j == x) ? c : mine; }
                if (sum == G) break;
                __builtin_amdgcn_s_sleep(1); if (++sp > (1u << 22)) break; }
            nloc = mine > 0u ? mine : 1u; nx = cnt > 0u ? cnt : 1u; st[0] = nloc; st[1] = nx; }
        const unsigned genx = xb_ld(&bar[XB_XGEN(x)]);
        const unsigned old = xb_add(&bar[XB_XSUB(x)], 1u);
        if (old + 1u == nloc) {
            xb_st(&bar[XB_XSUB(x)], 0u);
            __builtin_amdgcn_fence(__ATOMIC_RELEASE, "agent");
            asm volatile("s_waitcnt vmcnt(0)" ::: "memory");
            const unsigned gent = xb_ld(&bar[XB_TOPGEN]);
            const unsigned o2 = xb_add(&bar[XB_TOP], 1u);
            if (o2 + 1u == nx) { xb_st(&bar[XB_TOP], 0u); __builtin_amdgcn_fence(__ATOMIC_RELEASE, "agent"); asm volatile("s_waitcnt vmcnt(0)" ::: "memory"); xb_add(&bar[XB_TOPGEN], 1u); }
            else XB_SPIN(xb_ld(&bar[XB_TOPGEN]) == gent);
            __builtin_amdgcn_fence(__ATOMIC_ACQUIRE, "agent");
            xb_add(&bar[XB_XGEN(x)], 1u);
            asm volatile("s_waitcnt vmcnt(0)" ::: "memory");
        } else {
            XB_SPIN(xb_ld(&bar[XB_XGEN(x)]) == genx);
            __builtin_amdgcn_fence(__ATOMIC_ACQUIRE, "agent");
            asm volatile("s_waitcnt vmcnt(0)" ::: "memory");
        }
    }
    __syncthreads();
}

__global__ void __launch_bounds__(512) fwd_kernel(Params pp) {
    extern __shared__ __attribute__((aligned(16))) unsigned char lds_raw[];
    LAS unsigned char* lds = (LAS unsigned char*)lds_raw;
    if (pp.ph_hi > 1000) { cg::grid_group grid = cg::this_grid(); grid.sync(); }
    if (ltid() < 2) ((volatile LAS unsigned*)(lds + LDS_BYTES - 32))[ltid()] = 0u;
    __syncthreads();
    grid_barrier_post();
#pragma unroll 1
    for (int ph = pp.ph_lo; ph < pp.ph_hi; ++ph) {
        Params p = pp; { size_t zoff = 0; asm volatile("" : "+s"(zoff)); p.ws = pp.ws + zoff; }
        if (ph == 0) { if (lbid() == 0 && ltid() < 32) __hip_atomic_store(&g_q[ltid() * 64], 0u, __ATOMIC_RELAXED, __HIP_MEMORY_SCOPE_AGENT); for (int rep = 0; rep < REP_PREP; ++rep) phase_prep(lds, p); }
        else if (ph == NPHASE - 1) phase_final(p);
        else {
            int l = (ph - 1) / 6; const int sub = (ph - 1) % 6; asm volatile("" : "+s"(l));
            if (sub == 0) { for (int rep = 0; rep < REP_N; ++rep) phase_norm(p, l); }
            else if (sub == 1) {
                pg8::Gemm g{(const pg8::bf16_t*)(p.ws + WS_HX), (const pg8::bf16_t*)(p.ws + WS_WIN) + (size_t)l * NG1 * 2048, NTOK, NG1, 2048, 2048};
                pg8::StaticOrder S; S.init(NTOK, NG1, (int)gridDim.x, lbid());
                EpiIn E{(bf16_t*)(p.ws + WS_P), (float*)(p.ws + WS_GT)};
                for (int rep = 0; rep < REP_G1; ++rep) pg8::gemm_phase<EpiIn, pg8::StaticOrder>(lds, g, S, E);
                if (l < DEPTH - 1) {
                    __syncthreads();
                    for (int u = next_chunk(lds, 26 + l, 2u); u < T_WCONV; u = next_chunk(lds, 26 + l, 2u)) { wconv_task(lds, p, l + 1, u); if (u + 1 < T_WCONV) wconv_task(lds, p, l + 1, u + 1); }
                }
            } else if (sub == 2) {
                for (int t = lbid(); t < 272 + 480 + 128; t = next_task(lds, ph)) {
                    if (t < 272) { for (int rep = 0; rep < REP_M1; ++rep) m1_task(lds, p, l, t); }
                    else if (t < 752) { for (int rep = 0; rep < REP_R0; ++rep) r_task(lds, p, l, t - 272, 0); }
                    else { const int i = t - 752; if (i & 1) r_task(lds, p, l, 480 + (i >> 1), 0, 1, 2); else r_task(lds, p, l, 480 + (i >> 1), 0, 0, 1); } }
            } else if (sub == 3) { for (int rep = 0; rep < REP_M2; ++rep) phase_m2(p); }
            else if (sub == 4) {
                for (int t = lbid(); t < 544 + 136; t = next_task(lds, ph)) {
                    const bool last = (l == DEPTH - 1);
                    if (t >= 136) { const int mt3 = t - 136; if (last && ((mt3 >> 2) % 17) == 0) continue; for (int rep = 0; rep < REP_M3; ++rep) m3_task(lds, p, l, mt3); }
                    else { if (last && t < 8) continue; for (int rep = 0; rep < REP_R1; ++rep) rs_task(lds, p, l, t); } }
            } else {
                const int M = 8192;
                pg8::Gemm g{(const pg8::bf16_t*)(p.ws + WS_Y), (const pg8::bf16_t*)(p.ws + WS_WOUT) + (size_t)l * 2048 * 2048, M, 2048, 2048, 2048};
                pg8::StaticOrder S; S.init(M, 2048, (int)gridDim.x, lbid());
                EpiOut E{p, l};
                pg8::gemm_phase<EpiOut, pg8::StaticOrder>(lds, g, S, E);
                if (l < DEPTH - 1) { const int sid = (int)gridDim.x - 1 - lbid();
                    if (sid < 128) { const int kpart = sid & 7, unit = sid >> 3;
                        pg8::Gemm g2{(const pg8::bf16_t*)(p.ws + WS_Y) + kpart * 256, (const pg8::bf16_t*)(p.ws + WS_WOUT) + (size_t)l * 2048 * 2048 + kpart * 256, NTOK, 2048, 256, 2048};
                        OneUnit S2{32 + (unit >> 3), unit & 7};
                        EpiPart E2{(float*)(p.ws + WS_PART) + (size_t)kpart * 512 * 2048};
                        __syncthreads();
                        pg8::gemm_phase<EpiPart, OneUnit>(lds, g2, S2, E2); } }
            }
        }
        __syncthreads();
        if (ph + 1 < pp.ph_hi) { grid_barrier(lds); if (ph == pp.ph_lo + 1) grid_barrier_clear_census(); }
    }
}

#else
#define LDSDECL extern __shared__ __attribute__((aligned(16))) unsigned char lds_raw[]; LAS unsigned char* lds = (LAS unsigned char*)lds_raw;
__global__ void __launch_bounds__(512) k_prep(Params p) { LDSDECL phase_prep(lds, p); }
__global__ void __launch_bounds__(512) k_norm(Params p) { phase_norm(p, p.ph_lo); }
__global__ void __launch_bounds__(512) k_final(Params p) { phase_final(p); }
__global__ void __launch_bounds__(512) k_g1(Params p) { LDSDECL int l = p.ph_lo;
  pg8::Gemm g{(const pg8::bf16_t*)(p.ws + WS_HX), (const pg8::bf16_t*)(p.ws + WS_WIN) + (size_t)l * NG1 * 2048, NTOK, NG1, 2048, 2048};
  pg8::StaticOrder S; S.init(NTOK, NG1, (int)gridDim.x, lbid()); EpiIn E{(bf16_t*)(p.ws + WS_P), (float*)(p.ws + WS_GT)};
  pg8::gemm_phase<EpiIn, pg8::StaticOrder>(lds, g, S, E); }
__global__ void __launch_bounds__(512) k_g2(Params p) { LDSDECL int l = p.ph_lo; const int M = (l == DEPTH - 1) ? 8192 : NTOK;
  pg8::Gemm g{(const pg8::bf16_t*)(p.ws + WS_Y), (const pg8::bf16_t*)(p.ws + WS_WOUT) + (size_t)l * 2048 * 2048, M, 2048, 2048, 2048};
  pg8::StaticOrder S; S.init(M, 2048, (int)gridDim.x, lbid()); EpiOut E{p, l};
  pg8::gemm_phase<EpiOut, pg8::StaticOrder>(lds, g, S, E); }
__global__ void __launch_bounds__(512) k_m1(Params p) { LDSDECL for (int t = lbid(); t < 272; t += gridDim.x) m1_task(lds, p, p.ph_lo, t); }
__global__ void __launch_bounds__(512) k_m2(Params p) { phase_m2(p); }
__global__ void __launch_bounds__(512) k_m3(Params p) { LDSDECL for (int t = lbid(); t < 544; t += gridDim.x) m3_task(lds, p, p.ph_lo, t); }
__global__ void __launch_bounds__(512) k_r0(Params p) { LDSDECL for (int t = lbid(); t < 544; t += gridDim.x) r_task(lds, p, p.ph_lo, t, 0); }
__global__ void __launch_bounds__(512) k_r1(Params p) { LDSDECL for (int t = lbid(); t < 544; t += gridDim.x) r_task(lds, p, p.ph_lo, t, 1); }
#endif


#ifdef PROBE
__global__ void __launch_bounds__(512) k_dump(Params p, size_t off, int isbf, size_t nelem) {
    for (size_t i = (size_t)lbid() * 512 + ltid(); i < (size_t)8192 * 2048; i += (size_t)gridDim.x * 512) {
        const size_t j = i % nelem; p.out[i] = isbf ? bf2f(((const bf16_t*)(p.ws + off))[j]) : ((const float*)(p.ws + off))[j]; }
}
#endif

extern "C" void kernel_launch(void* const* d_in, const int* in_sizes, int n_in, void* d_out, int out_size, void* d_ws, size_t ws_size, hipStream_t stream) {
    static int grid = 0;
    if (grid == 0) {
        int dev = 0, cus = 0, per_cu = 0;
        hipGetDevice(&dev); hipDeviceGetAttribute(&cus, hipDeviceAttributeMultiprocessorCount, dev);
#if SINGLE_LAUNCH
        if (hipFuncSetAttribute((const void*)fwd_kernel, hipFuncAttributeMaxDynamicSharedMemorySize, LDS_BYTES) != hipSuccess) { fprintf(stderr, "hipFuncSetAttribute failed\n"); grid = -1; return; }
        if (hipOccupancyMaxActiveBlocksPerMultiprocessor(&per_cu, (const void*)fwd_kernel, 512, LDS_BYTES) != hipSuccess || per_cu < 1) { fprintf(stderr, "occupancy query: %d\n", per_cu); per_cu = 1; }
#else
        { const void* ks[] = {(const void*)k_prep, (const void*)k_g1, (const void*)k_g2, (const void*)k_m1, (const void*)k_m3, (const void*)k_r0, (const void*)k_r1};
          for (int i = 0; i < 7; ++i) if (hipFuncSetAttribute(ks[i], hipFuncAttributeMaxDynamicSharedMemorySize, LDS_BYTES) != hipSuccess) { fprintf(stderr, "hipFuncSetAttribute failed\n"); grid = -1; return; } }
        per_cu = 1;
#endif
        (void)hipGetLastError();
        grid = cus * 1;
        if (ws_size < WS_END) { fprintf(stderr, "workspace too small\n"); grid = -1; return; }
    }
    if (grid < 0) return;
    Params p{};
    p.x = (const float*)d_in[0]; p.c = (const float*)d_in[1]; p.ctx = (const float*)d_in[2]; p.c_ctx = (const float*)d_in[3]; p.w_mod = (const float*)d_in[4]; p.b_mod = (const float*)d_in[5];
    p.norm_g = (const float*)d_in[6]; p.w_in = (const float*)d_in[7]; p.b_gate = (const float*)d_in[8]; p.cqw = (const float*)d_in[9]; p.cqb = (const float*)d_in[10]; p.mng = (const float*)d_in[11];
    p.crw = (const float*)d_in[12]; p.crb = (const float*)d_in[13]; p.w_rg = (const float*)d_in[14]; p.b_rg = (const float*)d_in[15]; p.lam = (const float*)d_in[16]; p.w_out = (const float*)d_in[17];
    p.final_g = (const float*)d_in[18]; p.out = (float*)d_out; p.ws = (unsigned char*)d_ws;
#if SINGLE_LAUNCH
    p.ph_lo = 0; p.ph_hi = NPHASE;
    void* args[] = {&p};
    hipError_t e = hipLaunchCooperativeKernel((const void*)fwd_kernel, dim3(grid), dim3(512), args, LDS_BYTES, stream);
    if (e != hipSuccess) fprintf(stderr, "cooperative launch failed: %s (grid %d)\n", hipGetErrorString(e), grid);
#else
    p.ph_lo = 0; p.ph_hi = 0;
    hipLaunchKernelGGL(k_prep, dim3(grid), dim3(512), LDS_BYTES, stream, p);
    for (int l = 0; l < DEPTH; ++l) { p.ph_lo = l;
        hipLaunchKernelGGL(k_norm, dim3(grid), dim3(512), 0, stream, p);
#if defined(PROBE) && PROBE == 0
        hipLaunchKernelGGL(k_dump, dim3(grid), dim3(512), 0, stream, p, WS_HX, 1, (size_t)NTOK * 2048); return;
#endif
        hipLaunchKernelGGL(k_g1, dim3(grid), dim3(512), LDS_BYTES, stream, p);
#if defined(PROBE) && PROBE == 1
        hipLaunchKernelGGL(k_dump, dim3(grid), dim3(512), 0, stream, p, WS_P + (size_t)1024 * NPC * 2, 1, (size_t)8192 * 2048); return;
#endif
        hipLaunchKernelGGL(k_m1, dim3(grid), dim3(512), LDS_BYTES, stream, p);
        hipLaunchKernelGGL(k_r0, dim3(grid), dim3(512), LDS_BYTES, stream, p);
        hipLaunchKernelGGL(k_m2, dim3(grid), dim3(512), 0, stream, p);
#if defined(PROBE) && PROBE == 2
        hipLaunchKernelGGL(k_dump, dim3(grid), dim3(512), 0, stream, p, WS_CIN, 1, (size_t)272 * 32768); return;
#endif
        hipLaunchKernelGGL(k_m3, dim3(grid), dim3(512), LDS_BYTES, stream, p);
        hipLaunchKernelGGL(k_r1, dim3(grid), dim3(512), LDS_BYTES, stream, p);
#if defined(PROBE) && PROBE == 3
        hipLaunchKernelGGL(k_dump, dim3(grid), dim3(512), 0, stream, p, WS_Y, 1, (size_t)8192 * 2048); return;
#endif
        hipLaunchKernelGGL(k_g2, dim3(grid), dim3(512), LDS_BYTES, stream, p); }
    hipLaunchKernelGGL(k_final, dim3(grid), dim3(512), 0, stream, p);
#endif
}
```
